# Optimizing an MI355X kernel written in HIP

```python
import math
import jax, jax.numpy as jnp
from jax import lax
import numpy as np

D_MODEL = 1024
BATCH = 2
SEQ = 16384
DEPTH = 4

CHUNK = 64
N_META = 16
N_MIXERS = 3
N_POOL_LAYERS = (DEPTH + 2) // 3
N_DIFF_LAYERS = (DEPTH + 1) // 3
N_CONV_LAYERS = DEPTH // 3
POOL_WINDOWS = (2, 4, 8, 16)
POOL_GROUP = D_MODEL // len(POOL_WINDOWS)
DA_HEADS = 8
DA_HEAD_DIM = D_MODEL // (2 * DA_HEADS)
Q_BLOCK = 128
REL_BUCKETS = 32
REL_MAX_DIST = 128
CONV_WIDTH = 31
FFN_HIDDEN = ((8 * D_MODEL + 3 * 256 - 1) // (3 * 256)) * 256
RMS_EPS = 1e-6
LN_EPS = 1e-5
SUBLN_EPS = 1e-5

kernel_name = 'hybrid_pool_diffattn_conformer_trunk'


def rmsnorm(x, g, eps=RMS_EPS):
    xf = x.astype(jnp.float32)
    y = xf * lax.rsqrt(jnp.mean(xf * xf, axis=-1, keepdims=True) + eps)
    return (y * g.astype(jnp.float32)).astype(x.dtype)


def layernorm(x, g, b, eps=LN_EPS):
    xf = x.astype(jnp.float32)
    mu = jnp.mean(xf, axis=-1, keepdims=True)
    var = jnp.mean(jnp.square(xf - mu), axis=-1, keepdims=True)
    y = (xf - mu) * lax.rsqrt(var + eps)
    return (y * g.astype(jnp.float32) + b.astype(jnp.float32)).astype(x.dtype)


def chunk_id(pos):
    return jnp.where(pos < N_META, 0, 1 + (pos - N_META) // CHUNK)


def t5_bucket(rel):
    half = REL_BUCKETS // 2
    max_exact = half // 2
    offset = jnp.where(rel > 0, half, 0)
    n = jnp.abs(rel)
    log_ratio = jnp.log(jnp.maximum(n, 1).astype(jnp.float32) / max_exact) / math.log(REL_MAX_DIST / max_exact)
    large = jnp.minimum(max_exact + (log_ratio * (half - max_exact)).astype(jnp.int32), half - 1)
    return offset + jnp.where(n < max_exact, n, large)


def trailing_mean(xg, win):
    L = xg.shape[1]
    cs0 = jnp.pad(jnp.cumsum(xg.astype(jnp.float32), axis=1), ((0, 0), (1, 0), (0, 0)))
    lagged = jnp.pad(cs0, ((0, 0), (win, 0), (0, 0)))[:, 1:L + 1]
    count = jnp.minimum(jnp.arange(1, L + 1), win).astype(jnp.float32)[None, :, None]
    return (cs0[:, 1:] - lagged) / count


def pool_mixer(h, w, b, scale):
    B_, L, _ = h.shape
    groups = []
    for g, win in enumerate(POOL_WINDOWS):
        hg = h[..., g * POOL_GROUP:(g + 1) * POOL_GROUP]
        groups.append(trailing_mean(hg, win).astype(h.dtype) - hg)
    pooled = jnp.stack(groups, axis=2)
    mixed = jnp.einsum('blgc,gcd->blgd', pooled, w).reshape(B_, L, D_MODEL)
    return (mixed + b) * scale


def diff_attention(h, w_qkv, w_o, lq1, lk1, lq2, lk2, subln_g, rel_bias_table, lam_init):
    B_, L, _ = h.shape
    q, k, v = jnp.split(h @ w_qkv, 3, axis=-1)
    Lp = -(-L // Q_BLOCK) * Q_BLOCK
    pad = ((0, 0), (0, Lp - L), (0, 0))
    q = jnp.pad(q, pad).reshape(B_, Lp, DA_HEADS, 2, DA_HEAD_DIM)
    k = jnp.pad(k, pad).reshape(B_, Lp, DA_HEADS, 2, DA_HEAD_DIM)
    v = jnp.pad(v, pad).reshape(B_, Lp, DA_HEADS, 2 * DA_HEAD_DIM)
    f32 = jnp.float32
    lam = (jnp.exp(jnp.sum(lq1.astype(f32) * lk1.astype(f32)))
           - jnp.exp(jnp.sum(lq2.astype(f32) * lk2.astype(f32))) + lam_init)
    key_pos = jnp.arange(Lp, dtype=jnp.int32)
    key_chunk = chunk_id(key_pos)
    n_blk = Lp // Q_BLOCK
    qb = q.reshape(B_, n_blk, Q_BLOCK, DA_HEADS, 2, DA_HEAD_DIM).transpose(1, 0, 2, 3, 4, 5)
    scale = DA_HEAD_DIM ** -0.5

    def one_block(args):
        qi, blk = args
        q_pos = blk * Q_BLOCK + jnp.arange(Q_BLOCK, dtype=jnp.int32)
        s = jnp.einsum('bqhcd,bkhcd->bhcqk', qi, k).astype(f32) * scale
        bias = rel_bias_table.astype(f32)[t5_bucket(key_pos[None, :] - q_pos[:, None])]
        s = s + bias.transpose(2, 0, 1)[None, :, None]
        mask = key_chunk[None, :] <= chunk_id(q_pos)[:, None]
        p = jax.nn.softmax(jnp.where(mask, s, -jnp.inf), axis=-1)
        wts = p[:, :, 0] - lam * p[:, :, 1]
        return jnp.einsum('bhqk,bkhe->bqhe', wts.astype(v.dtype), v)

    o = lax.map(one_block, (qb, jnp.arange(n_blk, dtype=jnp.int32)))
    o = o.transpose(1, 0, 2, 3, 4).reshape(B_, Lp, DA_HEADS, 2 * DA_HEAD_DIM)[:, :L]
    o = rmsnorm(o, subln_g, SUBLN_EPS) * (1.0 - lam_init)
    return o.reshape(B_, L, D_MODEL) @ w_o


def conformer_conv(h, w_in, b_in, dw_w, dw_b, ln_g, ln_b, w_out, b_out):
    a, gate = jnp.split(h @ w_in + b_in, 2, axis=-1)
    u = a * jax.nn.sigmoid(gate)
    u = jnp.pad(u, ((0, 0), (CONV_WIDTH - 1, 0), (0, 0)))
    u = lax.conv_general_dilated(u, dw_w[:, None, :], window_strides=(1,), padding='VALID',
                                 dimension_numbers=('NWC', 'WIO', 'NWC'),
                                 feature_group_count=D_MODEL) + dw_b
    u = jax.nn.silu(layernorm(u, ln_g, ln_b))
    return u @ w_out + b_out


def swiglu_ffn(h, w_gate, w_up, w_down):
    return (jax.nn.silu(h @ w_gate) * (h @ w_up)) @ w_down


def _normal(k, shape, scale):
    return jax.random.normal(k, shape, jnp.float32) * scale


def setup_inputs(seed: int = 0) -> dict:
    key = jax.random.key(seed)
    ks = jax.random.split(key, 32)
    D, F = D_MODEL, FFN_HIDDEN
    return {
        'x': _normal(ks[0], (BATCH, SEQ, D), 1.0),
        'meta_tokens': _normal(ks[1], (N_META, D), 1.0),
        'norm_mix_g': 1.0 + _normal(ks[2], (DEPTH, D), 0.05),
        'norm_ffn_g': 1.0 + _normal(ks[3], (DEPTH, D), 0.05),
        'final_norm_g': 1.0 + _normal(ks[4], (D,), 0.05),
        'rel_bias_table': _normal(ks[5], (REL_BUCKETS, DA_HEADS), 0.5),
        'pool_w': _normal(ks[6], (N_POOL_LAYERS, len(POOL_WINDOWS), POOL_GROUP, POOL_GROUP), POOL_GROUP ** -0.5),
        'pool_b': _normal(ks[7], (N_POOL_LAYERS, D), 0.02),
        'pool_scale': 0.5 + _normal(ks[8], (N_POOL_LAYERS, D), 0.05),
        'attn_w_qkv': _normal(ks[9], (N_DIFF_LAYERS, D, 3 * D), D ** -0.5),
        'attn_w_o': _normal(ks[10], (N_DIFF_LAYERS, D, D), D ** -0.5),
        'attn_lambda_q1': _normal(ks[11], (N_DIFF_LAYERS, DA_HEAD_DIM), 0.1),
        'attn_lambda_k1': _normal(ks[12], (N_DIFF_LAYERS, DA_HEAD_DIM), 0.1),
        'attn_lambda_q2': _normal(ks[13], (N_DIFF_LAYERS, DA_HEAD_DIM), 0.1),
        'attn_lambda_k2': _normal(ks[14], (N_DIFF_LAYERS, DA_HEAD_DIM), 0.1),
        'attn_subln_g': 1.0 + _normal(ks[15], (N_DIFF_LAYERS, 2 * DA_HEAD_DIM), 0.05),
        'conv_w_in': _normal(ks[16], (N_CONV_LAYERS, D, 2 * D), D ** -0.5),
        'conv_b_in': _normal(ks[17], (N_CONV_LAYERS, 2 * D), 0.02),
        'conv_dw_w': _normal(ks[18], (N_CONV_LAYERS, CONV_WIDTH, D), CONV_WIDTH ** -0.5),
        'conv_dw_b': _normal(ks[19], (N_CONV_LAYERS, D), 0.02),
        'conv_ln_g': 1.0 + _normal(ks[20], (N_CONV_LAYERS, D), 0.05),
        'conv_ln_b': _normal(ks[21], (N_CONV_LAYERS, D), 0.02),
        'conv_w_out': _normal(ks[22], (N_CONV_LAYERS, D, D), D ** -0.5),
        'conv_b_out': _normal(ks[23], (N_CONV_LAYERS, D), 0.02),
        'ffn_w_gate': _normal(ks[24], (DEPTH, D, F), D ** -0.5),
        'ffn_w_up': _normal(ks[25], (DEPTH, D, F), D ** -0.5),
        'ffn_w_down': _normal(ks[26], (DEPTH, F, D), F ** -0.5),
    }


def reference(x, meta_tokens, norm_mix_g, norm_ffn_g, final_norm_g, rel_bias_table,
              pool_w, pool_b, pool_scale,
              attn_w_qkv, attn_w_o, attn_lambda_q1, attn_lambda_k1, attn_lambda_q2, attn_lambda_k2, attn_subln_g,
              conv_w_in, conv_b_in, conv_dw_w, conv_dw_b, conv_ln_g, conv_ln_b, conv_w_out, conv_b_out,
              ffn_w_gate, ffn_w_up, ffn_w_down):
    B_ = x.shape[0]
    meta = jnp.broadcast_to(meta_tokens[None].astype(x.dtype), (B_, N_META, D_MODEL))
    h = jnp.concatenate([meta, x], axis=1)
    for i in range(DEPTH):
        mixer, j = i % N_MIXERS, i // N_MIXERS
        y = rmsnorm(h, norm_mix_g[i])
        if mixer == 0:
            y = pool_mixer(y, pool_w[j], pool_b[j], pool_scale[j])
        elif mixer == 1:
            lam_init = 0.8 - 0.6 * math.exp(-0.3 * i)
            y = diff_attention(y, attn_w_qkv[j], attn_w_o[j], attn_lambda_q1[j], attn_lambda_k1[j],
                               attn_lambda_q2[j], attn_lambda_k2[j], attn_subln_g[j], rel_bias_table, lam_init)
        else:
            y = conformer_conv(y, conv_w_in[j], conv_b_in[j], conv_dw_w[j], conv_dw_b[j],
                               conv_ln_g[j], conv_ln_b[j], conv_w_out[j], conv_b_out[j])
        h = h + y
        h = h + swiglu_ffn(rmsnorm(h, norm_ffn_g[i]), ffn_w_gate[i], ffn_w_up[i], ffn_w_down[i])
    return rmsnorm(h[:, N_META:], final_norm_g)
```

```cpp
#include <hip/hip_runtime.h>
#include <hip/hip_cooperative_groups.h>
#include <cstdio>
#include <cstdint>
namespace cg = cooperative_groups;

#define LAS __attribute__((address_space(3)))
typedef unsigned short bf16_t;
typedef short bf16x8 __attribute__((ext_vector_type(8)));
typedef short s16x4 __attribute__((ext_vector_type(4)));
typedef float f32x4 __attribute__((ext_vector_type(4)));
typedef float f32x16 __attribute__((ext_vector_type(16)));
typedef unsigned u32x4 __attribute__((ext_vector_type(4)));
typedef unsigned u32x2 __attribute__((ext_vector_type(2)));
typedef float f32x2_t __attribute__((ext_vector_type(2)));
typedef __bf16 bf16x2_t __attribute__((ext_vector_type(2)));

constexpr int DM = 1024, BATCH = 2, SEQ = 16384, NMETA = 16, LSEQ = SEQ + NMETA;
constexpr int MROWS = BATCH * LSEQ;
constexpr int MP = 33024;
constexpr int FF = 2816, NGU = 2 * FF;
constexpr int NQKV = 3 * DM;
constexpr float LOG2E = 1.4426950408889634f;
constexpr float QSCALE = 0.125f * LOG2E;

constexpr size_t SZ_H = (size_t)MP * DM * 4, SZ_Y = (size_t)MP * DM * 2, SZ_BIG = (size_t)MP * NQKV * 2;
constexpr size_t WS_H = 0, WS_Y = WS_H + SZ_H, WS_BIG = WS_Y + SZ_Y, WS_W = WS_BIG + SZ_BIG;
constexpr size_t SZ_WGU = (size_t)NGU * DM * 2, SZ_WD = (size_t)DM * FF * 2, SZ_SQ = (size_t)DM * DM * 2;
constexpr size_t WS_WGU = WS_W, WS_WD = WS_WGU + 4 * SZ_WGU, WS_WQKV = WS_WD + 4 * SZ_WD, WS_WO = WS_WQKV + 3 * SZ_SQ,
                 WS_WIN = WS_WO + SZ_SQ, WS_WOUT = WS_WIN + 2 * SZ_SQ, WS_WP = WS_WOUT + SZ_SQ, WS_SS = WS_WP + 2 * 4 * 256 * 256 * 2, WS_SSM = WS_SS + (size_t)MP * 16 * 4, WS_CTL = WS_SSM + 16 * 64 * 4, WS_END = WS_CTL + 16384;

constexpr int LDS_CTL = 131072 + 4096;
constexpr int LDS_BYTES = LDS_CTL + 64;

__device__ __forceinline__ unsigned f2bf(float f) { unsigned u = __builtin_bit_cast(unsigned, f); return (u + 0x7fffu + ((u >> 16) & 1u)) >> 16; }
__device__ __forceinline__ unsigned pk2(float lo, float hi) { f32x2_t v = {lo, hi}; bf16x2_t b = __builtin_convertvector(v, bf16x2_t); return __builtin_bit_cast(unsigned, b); }
__device__ __forceinline__ float bflo(unsigned w) { return __builtin_bit_cast(float, w << 16); }
__device__ __forceinline__ float bfhi(unsigned w) { return __builtin_bit_cast(float, w & 0xffff0000u); }
__device__ __forceinline__ float wave_sum(float v) {
#pragma unroll
    for (int o = 1; o < 64; o <<= 1) v += __shfl_xor(v, o);
    return v;
}
__device__ __forceinline__ float sigmoidf_(float x) { return __builtin_amdgcn_rcpf(1.0f + __expf(-x)); }
__device__ __forceinline__ float sum16(const float* p) { const f32x4 a = *(const f32x4*)p, b = *(const f32x4*)(p + 4), c = *(const f32x4*)(p + 8), d = *(const f32x4*)(p + 12); const f32x4 t = (a + b) + (c + d); return (t[0] + t[1]) + (t[2] + t[3]); }
__device__ __forceinline__ float rs16(const float* ssp, int row) { return 1.0f / sqrtf(sum16(ssp + (size_t)row * 16) * (1.0f / DM) + 1e-6f); }
__device__ __forceinline__ float rs64(const float* ssm, int r) { const float* p = ssm + r * 64; return 1.0f / sqrtf(((sum16(p) + sum16(p + 16)) + (sum16(p + 32) + sum16(p + 48))) * (1.0f / DM) + 1e-6f); }

namespace pg8 {
constexpr int BM = 256, BK = 64, HALF = 128, HTB = HALF * BK * 2, STAGE_BYTES = 8 * HTB, NXCD = 8, WGM = 8;
__host__ __device__ __forceinline__ int lds_byte(int r, int c) { const int st = (r >> 4) * 2 + (c >> 5), rr = r & 15, cc = c & 31, ob = rr * 64 + cc * 2; return st * 1024 + (ob ^ (((ob >> 9) & 1) << 5)); }
__host__ __device__ __forceinline__ void stage_rc(int b, int& R, int& C) { const int st = b / 1024, sb = b % 1024, swz = sb ^ (((sb >> 9) & 1) << 5); R = (st >> 1) * 16 + swz / 64; C = (st & 1) * 32 + (swz % 64) / 2; }
__host__ __device__ __forceinline__ int perm32(int rho) { const int n = rho >> 4, i = rho & 15; return 8 * (i >> 2) + 4 * n + (i & 3); }

struct Unit { int pm, pn; };
__device__ __forceinline__ int rowstart(int pm) { return pm * 256 + 16 * ((pm >> 6) + 1); }
struct Gemm { const bf16_t* A; const bf16_t* Bt; int M, N, K, lda, grouped; };

struct StaticOrder {
    int nM, nN, nwg, G, c;
    __device__ void init(int M, int N, int G_, int c_) { nM = M / BM; nN = N / BM; nwg = nM * nN; G = G_; c = c_; }
    __device__ bool next(int i, Unit& u) const {
        const long L = (long)i * G + c; if (L >= nwg) return false;
        int wgid = (int)L; { const int q = nwg / NXCD, r = nwg % NXCD, xcd = wgid % NXCD, off = wgid / NXCD; wgid = (xcd < r ? xcd * (q + 1) : r * (q + 1) + (xcd - r) * q) + off; }
        const int nig = WGM * nN, gid = wgid / nig, fm = gid * WGM, gsz = (nM - fm) < WGM ? (nM - fm) : WGM;
        u.pm = fm + ((wgid % nig) % gsz); u.pn = (wgid % nig) / gsz; return true;
    }
};

template <class Epi>
__device__ __forceinline__ void gemm_phase(LAS unsigned char* lds, const Gemm g, const StaticOrder& S, const Epi& E) {
    const int tid = threadIdx.x, wid = __builtin_amdgcn_readfirstlane(tid >> 6), lane = tid & 63, wr = wid >> 2, wc = wid & 3, fr = lane & 15, fq = lane >> 4;
    const int K = g.K, nt = K / BK;
    unsigned voffA[2], voffB[2];
#pragma unroll
    for (int i = 0; i < 2; ++i) { int R, C; stage_rc(tid * 16 + i * 8192, R, C); const int Rb = Epi::PERM ? ((R & ~31) + perm32(R & 31)) : R;
        voffA[i] = (unsigned)(R * g.lda + C) * 2u; voffB[i] = (unsigned)(Rb * K + C) * 2u; }
    const size_t kstep = (size_t)(BK * 2);
    const size_t hstepA = (size_t)HALF * g.lda * 2, hstepB = (size_t)HALF * K * 2;
    const size_t rstepA = (size_t)g.lda * 2, tstepB = 2 * hstepB;
    const size_t gstepA = g.grouped ? (size_t)K * 2 : 0;
    const unsigned ldsw = (unsigned)wid * 1024u;
    const int aoff = lds_byte(wr * 64 + fr, fq * 8), boff = lds_byte(wc * 32 + fr, fq * 8);
#define PG8_SA(b, h) (((b) * 2 + (h)) * HTB)
#define PG8_SB(b, h) ((4 + (b) * 2 + (h)) * HTB)
#define PG8_STAGE(bufoff, gbase, voff) do { _Pragma("unroll") for (int _i = 0; _i < 2; ++_i) \
        __builtin_amdgcn_global_load_lds((const unsigned*)((const char*)(gbase) + (voff)[_i]), (LAS unsigned*)(lds + (bufoff) + ldsw + _i * 8192), 16, 0, 0); } while (0)
#define PG8_LDA(dst, b, h) do { _Pragma("unroll") for (int m = 0; m < 4; ++m) _Pragma("unroll") for (int k = 0; k < 2; ++k) dst[m][k] = *(const LAS bf16x8*)(lds + PG8_SA(b, h) + aoff + m * 2048 + k * 1024); } while (0)
#define PG8_LDB(dst, b, h) do { _Pragma("unroll") for (int n = 0; n < 2; ++n) _Pragma("unroll") for (int k = 0; k < 2; ++k) dst[n][k] = *(const LAS bf16x8*)(lds + PG8_SB(b, h) + boff + n * 2048 + k * 1024); } while (0)
#define PG8_MMA(ai, bj, At, Bt) do { __builtin_amdgcn_s_setprio(1); _Pragma("unroll") for (int m = 0; m < 4; ++m) _Pragma("unroll") for (int n = 0; n < 2; ++n) _Pragma("unroll") for (int k = 0; k < 2; ++k) \
        acc[ai][bj][m][n] = __builtin_amdgcn_mfma_f32_16x16x32_bf16(Bt[n][k], At[m][k], acc[ai][bj][m][n], 0, 0, 0); __builtin_amdgcn_s_setprio(0); } while (0)
#define PG8_WAIT_V(n) asm volatile("s_waitcnt vmcnt(" #n ")" ::: "memory")
#define PG8_WAIT_L(n) asm volatile("s_waitcnt lgkmcnt(" #n ")" ::: "memory")
#define PG8_BAR __builtin_amdgcn_s_barrier()
#define PG8_SCHED __builtin_amdgcn_sched_barrier(0)
    Unit cur, nxt; int ui = 0;
    if (!S.next(0, cur)) return;
    f32x4 acc[2][2][4][2];
#pragma unroll
    for (int a = 0; a < 2; ++a)
#pragma unroll
        for (int b = 0; b < 2; ++b)
#pragma unroll
            for (int m = 0; m < 4; ++m)
#pragma unroll
                for (int n = 0; n < 2; ++n) acc[a][b][m][n] = (f32x4){0.f, 0.f, 0.f, 0.f};
    bf16x8 At[4][2], B0[2][2], B1[2][2];
    const char* cA = (const char*)g.A + (size_t)rowstart(cur.pm) * rstepA + (size_t)cur.pn * gstepA; const char* cB = (const char*)g.Bt + (size_t)cur.pn * tstepB;
    PG8_STAGE(PG8_SB(0, 0), cB, voffB); PG8_STAGE(PG8_SB(0, 1), cB + hstepB, voffB); PG8_STAGE(PG8_SA(0, 0), cA, voffA); PG8_STAGE(PG8_SA(0, 1), cA + hstepA, voffA);
    if (wr == 1) PG8_BAR;
    PG8_WAIT_V(2); PG8_BAR;
    PG8_STAGE(PG8_SB(1, 0), cB + kstep, voffB); PG8_STAGE(PG8_SA(1, 0), cA + kstep, voffA); PG8_STAGE(PG8_SB(1, 1), cB + hstepB + kstep, voffB);
    PG8_WAIT_V(6); PG8_BAR;
    for (;;) {
        const bool has_next = S.next(ui + 1, nxt);
        const char* nA = has_next ? (const char*)g.A + (size_t)rowstart(nxt.pm) * rstepA + (size_t)nxt.pn * gstepA : cA; const char* nB = has_next ? (const char*)g.Bt + (size_t)nxt.pn * tstepB : cB;
        for (int t = 0; t < nt; t += 2) {
            const bool last = (t == nt - 2);
            const char* a1 = cA + (size_t)(t + 1) * kstep;
            const char* a2 = last ? nA : cA + (size_t)(t + 2) * kstep; const char* b2 = last ? nB : cB + (size_t)(t + 2) * kstep;
            const char* a3 = a2 + kstep; const char* b3 = b2 + kstep;
            PG8_LDB(B0, 0, 0); PG8_LDB(B1, 0, 1); PG8_SCHED; PG8_LDA(At, 0, 0); PG8_STAGE(PG8_SA(1, 1), a1 + hstepA, voffA);
            PG8_WAIT_V(8); PG8_WAIT_L(0); PG8_BAR; PG8_MMA(0, 0, At, B0); PG8_MMA(0, 1, At, B1); PG8_BAR; PG8_SCHED;
            PG8_LDA(At, 0, 1); PG8_STAGE(PG8_SB(0, 0), b2, voffB); PG8_STAGE(PG8_SB(0, 1), b2 + hstepB, voffB); PG8_STAGE(PG8_SA(0, 0), a2, voffA);
            PG8_WAIT_V(8); PG8_WAIT_L(0); PG8_BAR; PG8_MMA(1, 0, At, B0); PG8_MMA(1, 1, At, B1); PG8_BAR; PG8_SCHED;
            PG8_LDB(B0, 1, 0); PG8_LDB(B1, 1, 1); PG8_SCHED; PG8_LDA(At, 1, 0); PG8_STAGE(PG8_SA(0, 1), a2 + hstepA, voffA);
            PG8_WAIT_V(8); PG8_WAIT_L(0); PG8_BAR; PG8_MMA(0, 0, At, B0); PG8_MMA(0, 1, At, B1); PG8_BAR; PG8_SCHED;
            PG8_LDA(At, 1, 1); PG8_STAGE(PG8_SB(1, 0), b3, voffB); PG8_STAGE(PG8_SB(1, 1), b3 + hstepB, voffB); PG8_STAGE(PG8_SA(1, 0), a3, voffA);
            PG8_WAIT_V(8); PG8_WAIT_L(0); PG8_BAR; PG8_MMA(1, 0, At, B0); PG8_MMA(1, 1, At, B1); PG8_BAR; PG8_SCHED;
        }
        if (wr == 0) PG8_BAR;
        E(acc, cur, wr, wc, fr, fq);
        if (!has_next) break;
#pragma unroll
        for (int a = 0; a < 2; ++a)
#pragma unroll
            for (int b = 0; b < 2; ++b)
#pragma unroll
                for (int m = 0; m < 4; ++m)
#pragma unroll
                    for (int n = 0; n < 2; ++n) acc[a][b][m][n] = (f32x4){0.f, 0.f, 0.f, 0.f};
        cur = nxt; cA = nA; cB = nB; ++ui;
        if (wr == 1) PG8_BAR;
    }
    PG8_WAIT_V(0);
    PG8_BAR;
#undef PG8_SA
#undef PG8_SB
#undef PG8_STAGE
#undef PG8_LDA
#undef PG8_LDB
#undef PG8_MMA
#undef PG8_WAIT_V
#undef PG8_WAIT_L
#undef PG8_BAR
#undef PG8_SCHED
}

typedef f32x4 AccT[2][2][4][2];
struct RsTab { const LAS float* tab; int p0, p1, p2, p3; const float* ss;
    __device__ __forceinline__ float get(int pm, int rloc, int row) const {
        const int slot = pm == p0 ? 0 : (pm == p1 ? 1 : (pm == p2 ? 2 : (pm == p3 ? 3 : -1)));
        return slot >= 0 ? tab[slot * 256 + rloc] : rs16(ss, row); }
};
__device__ __forceinline__ void build_rstab(RsTab& T, LAS unsigned char* lds, const float* ss, const StaticOrder& S) {
    int p0 = -1, p1 = -1, p2 = -1, p3 = -1;
    for (int i = 0;; ++i) { Unit u; if (!S.next(i, u)) break; const int pm = u.pm;
        if (pm == p0 || pm == p1 || pm == p2 || pm == p3) continue;
        if (p0 < 0) p0 = pm; else if (p1 < 0) p1 = pm; else if (p2 < 0) p2 = pm; else if (p3 < 0) p3 = pm; }
    LAS float* tab = (LAS float*)(lds + STAGE_BYTES);
    const int tid = threadIdx.x, rl = tid & 255, sl = tid >> 8;
    { const int pa = sl == 0 ? p0 : p1; if (pa >= 0) tab[sl * 256 + rl] = rs16(ss, rowstart(pa) + rl); }
    { const int pb = sl == 0 ? p2 : p3; if (pb >= 0) tab[(2 + sl) * 256 + rl] = rs16(ss, rowstart(pb) + rl); }
    __syncthreads();
    T.tab = tab; T.p0 = p0; T.p1 = p1; T.p2 = p2; T.p3 = p3; T.ss = ss;
}
struct EpiSwiGLU { static constexpr bool PERM = true, USE_RS = true; bf16_t* O; int ldo; const float* ss; RsTab T;
    __device__ __forceinline__ void operator()(const AccT& acc, const Unit& u, int wr, int wc, int fr, int fq) const {
        const int row0 = rowstart(u.pm) + wr * 64 + fr, j0 = u.pn * 128 + wc * 32 + 8 * fq;
#pragma unroll
        for (int ai = 0; ai < 2; ++ai)
#pragma unroll
            for (int m = 0; m < 4; ++m) { const int row = row0 + ai * HALF + m * 16; float v[8]; const float rs = T.get(u.pm, wr * 64 + fr + ai * HALF + m * 16, row);
#pragma unroll
                for (int n = 0; n < 2; ++n)
#pragma unroll
                    for (int e = 0; e < 4; ++e) { const float gt = acc[ai][0][m][n][e] * rs, up = acc[ai][1][m][n][e] * rs; v[4 * n + e] = gt * sigmoidf_(gt) * up; }
                u32x4 w; w.x = pk2(v[0], v[1]); w.y = pk2(v[2], v[3]); w.z = pk2(v[4], v[5]); w.w = pk2(v[6], v[7]);
                *(u32x4*)(O + (size_t)row * ldo + j0) = w; }
    }
};
struct EpiGLU { static constexpr bool PERM = true, USE_RS = true; bf16_t* O; const float* bias; const float* ss; RsTab T;
    __device__ __forceinline__ void operator()(const AccT& acc, const Unit& u, int wr, int wc, int fr, int fq) const {
        const int row0 = rowstart(u.pm) + wr * 64 + fr, j0 = u.pn * 128 + wc * 32 + 8 * fq;
        float ba[8], bg[8];
#pragma unroll
        for (int e = 0; e < 8; ++e) { ba[e] = bias[j0 + e]; bg[e] = bias[DM + j0 + e]; }
#pragma unroll
        for (int ai = 0; ai < 2; ++ai)
#pragma unroll
            for (int m = 0; m < 4; ++m) { const int row = row0 + ai * HALF + m * 16; float v[8]; const float rs = T.get(u.pm, wr * 64 + fr + ai * HALF + m * 16, row);
#pragma unroll
                for (int n = 0; n < 2; ++n)
#pragma unroll
                    for (int e = 0; e < 4; ++e) { const float a = acc[ai][0][m][n][e] * rs + ba[4 * n + e], gt = acc[ai][1][m][n][e] * rs + bg[4 * n + e]; v[4 * n + e] = a * sigmoidf_(gt); }
                u32x4 w; w.x = pk2(v[0], v[1]); w.y = pk2(v[2], v[3]); w.z = pk2(v[4], v[5]); w.w = pk2(v[6], v[7]);
                *(u32x4*)(O + (size_t)row * DM + j0) = w; }
    }
};
constexpr int KV_TILES = 258; constexpr size_t KV_BH_BYTES = (size_t)KV_TILES * 16384;
struct EpiQKV { static constexpr bool PERM = true, USE_RS = true; bf16_t* Q; unsigned char* Kimg; unsigned char* Vimg; const float* ss; RsTab T;
    __device__ __forceinline__ void operator()(const AccT& acc, const Unit& u, int wr, int wc, int fr, int fq) const {
        const int row0 = rowstart(u.pm) + wr * 64 + fr, c00 = u.pn * BM + wc * 32 + 8 * fq;
        const int region = (u.pn * BM) >> 10, b = u.pm >> 6;
        const float sc = region == 0 ? QSCALE : 1.0f;
#pragma unroll
        for (int ai = 0; ai < 2; ++ai)
#pragma unroll
            for (int m = 0; m < 4; ++m) { const int row = row0 + ai * HALF + m * 16; const float rs = sc * T.get(u.pm, wr * 64 + fr + ai * HALF + m * 16, row);
                const int pos = row - b * LSEQ - NMETA, tile = 1 + (pos >> 6), rin = pos & 63;
#pragma unroll
                for (int bj = 0; bj < 2; ++bj) { const f32x4 v0 = acc[ai][bj][m][0] * rs, v1 = acc[ai][bj][m][1] * rs;
                    u32x4 w; w.x = pk2(v0[0], v0[1]); w.y = pk2(v0[2], v0[3]); w.z = pk2(v1[0], v1[1]); w.w = pk2(v1[2], v1[3]);
                    const int c = c00 + bj * HALF;
                    if (region == 0) *(u32x4*)(Q + (size_t)row * DM + c) = w;
                    else { const int cc = c & 1023, h = cc >> 7, d = cc & 127; const size_t tb = (size_t)(b * 8 + h) * KV_BH_BYTES + (size_t)tile * 16384;
                        if (region == 1) *(u32x4*)(Kimg + tb + (d >> 3) * 1024 + rin * 16) = w;
                        else *(u32x4*)(Vimg + tb + (d >> 5) * 4096 + rin * 64 + (d & 31) * 2) = w; } } }
    }
};
struct EpiResid { static constexpr bool PERM = true, USE_RS = false; float* H; const float* bias; const float* scale; bf16_t* HB; float* ss_out;
    __device__ __forceinline__ void operator()(const AccT& acc, const Unit& u, int wr, int wc, int fr, int fq) const {
        const int row0 = rowstart(u.pm) + wr * 64 + fr, col0 = u.pn * BM + wc * 32 + 8 * fq;
        f32x4 bv[2][2], sv[2][2];
#pragma unroll
        for (int bj = 0; bj < 2; ++bj)
#pragma unroll
            for (int n = 0; n < 2; ++n) { bv[bj][n] = bias ? *(const f32x4*)(bias + col0 + bj * HALF + n * 4) : (f32x4){0.f, 0.f, 0.f, 0.f};
                                          sv[bj][n] = scale ? *(const f32x4*)(scale + col0 + bj * HALF + n * 4) : (f32x4){1.f, 1.f, 1.f, 1.f}; }
#pragma unroll
        for (int ai = 0; ai < 2; ++ai)
#pragma unroll
            for (int m = 0; m < 4; ++m) { const int row = row0 + ai * HALF + m * 16;
                { bf16_t* hbp = HB + (size_t)row * DM + col0; float sq = 0.f;
#pragma unroll
                    for (int bj = 0; bj < 2; ++bj) { u32x4* p = (u32x4*)(hbp + bj * HALF); const u32x4 ho = *p;
                        const f32x4 h0 = {bflo(ho.x), bfhi(ho.x), bflo(ho.y), bfhi(ho.y)}, h1 = {bflo(ho.z), bfhi(ho.z), bflo(ho.w), bfhi(ho.w)};
                        const f32x4 a0 = h0 + (acc[ai][bj][m][0] + bv[bj][0]) * sv[bj][0], a1 = h1 + (acc[ai][bj][m][1] + bv[bj][1]) * sv[bj][1];
                        u32x4 w; w.x = pk2(a0[0], a0[1]); w.y = pk2(a0[2], a0[3]); w.z = pk2(a1[0], a1[1]); w.w = pk2(a1[2], a1[3]); *p = w;
                        sq += ((a0[0] * a0[0] + a0[1] * a0[1]) + (a0[2] * a0[2] + a0[3] * a0[3])) + ((a1[0] * a1[0] + a1[1] * a1[1]) + (a1[2] * a1[2] + a1[3] * a1[3])); }
                    sq += __shfl_xor(sq, 16); sq += __shfl_xor(sq, 32);
                    if (fq == 0) ss_out[(size_t)row * 16 + u.pn * 4 + wc] = sq; } }
    }
};
template <class Epi> __device__ __forceinline__ void run_gemm(LAS unsigned char* lds, const bf16_t* A, int lda, const bf16_t* Bt, int N, int K, int grouped, Epi& E) {
    Gemm g; g.A = A; g.Bt = Bt; g.M = BATCH * SEQ; g.N = N; g.K = K; g.lda = lda; g.grouped = grouped;
    StaticOrder S; S.init(BATCH * SEQ, N, (int)gridDim.x, (int)blockIdx.x);
    if constexpr (Epi::USE_RS) build_rstab(E.T, lds, E.ss, S);
    gemm_phase<Epi>(lds, g, S, E);
}

struct MEpiSwiGLU { static constexpr bool PAIR = true; bf16_t* O; const float* ss;
    __device__ __forceinline__ float pre(int lane) const { return rs64(ss, lane & 15); }
    __device__ __forceinline__ void operator()(const f32x4& g_, const f32x4& u_, int task, int lane, float rs) const {
        const f32x4 g = g_ * rs, u = u_ * rs;
        const int r = lane & 15, j = (task >> 3) * 128 + (task & 7) * 16 + 4 * (lane >> 4);
        u32x2 w; w.x = pk2(g[0] * sigmoidf_(g[0]) * u[0], g[1] * sigmoidf_(g[1]) * u[1]); w.y = pk2(g[2] * sigmoidf_(g[2]) * u[2], g[3] * sigmoidf_(g[3]) * u[3]);
        *(u32x2*)(O + (size_t)r * FF + j) = w; *(u32x2*)(O + (size_t)(LSEQ + r) * FF + j) = w; }
};
struct MEpiGLU { static constexpr bool PAIR = true; bf16_t* O; const float* bias; const float* ss;
    __device__ __forceinline__ float pre(int lane) const { return rs64(ss, lane & 15); }
    __device__ __forceinline__ void operator()(const f32x4& av, const f32x4& gv, int task, int lane, float rs) const {
        const int r = lane & 15, j = (task >> 3) * 128 + (task & 7) * 16 + 4 * (lane >> 4); float v[4];
#pragma unroll
        for (int e = 0; e < 4; ++e) v[e] = (av[e] * rs + bias[j + e]) * sigmoidf_(gv[e] * rs + bias[DM + j + e]);
        u32x2 w; w.x = pk2(v[0], v[1]); w.y = pk2(v[2], v[3]);
        *(u32x2*)(O + (size_t)r * DM + j) = w; *(u32x2*)(O + (size_t)(LSEQ + r) * DM + j) = w; }
};
struct MEpiQKV { static constexpr bool PAIR = false; bf16_t* Q; unsigned char* Kimg; unsigned char* Vimg; const float* ss;
    __device__ __forceinline__ float pre(int lane) const { return rs64(ss, lane & 15); }
    __device__ __forceinline__ void operator()(const f32x4& v, const f32x4&, int task, int lane, float rs) const {
        const int r = lane & 15, c = task * 16 + 4 * (lane >> 4); const float sc = (c < DM ? QSCALE : 1.0f) * rs;
        u32x2 w; w.x = pk2(v[0] * sc, v[1] * sc); w.y = pk2(v[2] * sc, v[3] * sc);
        const int region = c >> 10, cc = c & 1023, h = cc >> 7, d = cc & 127;
#pragma unroll
        for (int b = 0; b < 2; ++b) {
            if (region == 0) *(u32x2*)(Q + (size_t)(b * LSEQ + r) * DM + c) = w;
            else { const size_t tb = (size_t)(b * 8 + h) * KV_BH_BYTES;
                if (region == 1) *(u32x2*)(Kimg + tb + (d >> 3) * 1024 + r * 16 + (d & 7) * 2) = w;
                else *(u32x2*)(Vimg + tb + (d >> 5) * 4096 + r * 64 + (d & 31) * 2) = w; } } }
};
struct MEpiResid { static constexpr bool PAIR = false; float* H; const float* bias; const float* scale; bf16_t* HB; float* ss_out;
    __device__ __forceinline__ float pre(int) const { return 1.0f; }
    __device__ __forceinline__ void operator()(const f32x4& v, const f32x4&, int task, int lane, float) const {
        const int r = lane & 15, c = task * 16 + 4 * (lane >> 4);
        const f32x4 bv = bias ? *(const f32x4*)(bias + c) : (f32x4){0.f, 0.f, 0.f, 0.f}, sv = scale ? *(const f32x4*)(scale + c) : (f32x4){1.f, 1.f, 1.f, 1.f};
        const f32x4 d = (v + bv) * sv;
        const u32x2 ho = *(const u32x2*)(HB + (size_t)r * DM + c); const f32x4 h0 = {bflo(ho.x), bfhi(ho.x), bflo(ho.y), bfhi(ho.y)};
        const f32x4 hn = h0 + d;
        u32x2 w; w.x = pk2(hn[0], hn[1]); w.y = pk2(hn[2], hn[3]); *(u32x2*)(HB + (size_t)r * DM + c) = w; *(u32x2*)(HB + (size_t)(LSEQ + r) * DM + c) = w;
        float sq = (hn[0] * hn[0] + hn[1] * hn[1]) + (hn[2] * hn[2] + hn[3] * hn[3]); sq += __shfl_xor(sq, 16); sq += __shfl_xor(sq, 32);
        if ((lane >> 4) == 0) ss_out[r * 64 + task] = sq; }
};
template <int K, class MEpi> __device__ __forceinline__ void meta_gemm(LAS unsigned char* lds, const bf16_t* A, int lda, const bf16_t* Bt, int ntasks, int grouped, const MEpi& E) {
    const int tid = threadIdx.x, lane = tid & 63, wid = __builtin_amdgcn_readfirstlane(tid >> 6), G = (int)gridDim.x;
    constexpr int kw = K / 8;
    LAS f32x4* part = (LAS f32x4*)lds;
    for (int task = (int)blockIdx.x; task < ntasks; task += G) {
        const int nb0 = MEpi::PAIR ? (task >> 3) * 256 + (task & 7) * 16 : task * 16;
        const int acol = grouped ? (task >> 4) * 256 : 0;
        const bf16_t* ap = A + (size_t)(lane & 15) * lda + acol + wid * kw + 8 * (lane >> 4);
        const bf16_t* bp = Bt + (size_t)(nb0 + (lane & 15)) * K + wid * kw + 8 * (lane >> 4);
        f32x4 acc0 = {0.f, 0.f, 0.f, 0.f}, acc1 = {0.f, 0.f, 0.f, 0.f};
        float rsv = 1.0f; if (wid == 0) rsv = E.pre(lane);
        constexpr int NS = kw / 32;
        bf16x8 af[NS], b0[NS], b1[MEpi::PAIR ? NS : 1];
#pragma unroll
        for (int i = 0; i < NS; ++i) { af[i] = *(const bf16x8*)(ap + 32 * i); b0[i] = *(const bf16x8*)(bp + 32 * i); if (MEpi::PAIR) b1[i] = *(const bf16x8*)(bp + (size_t)128 * K + 32 * i); }
#pragma unroll
        for (int i = 0; i < NS; ++i) { acc0 = __builtin_amdgcn_mfma_f32_16x16x32_bf16(b0[i], af[i], acc0, 0, 0, 0);
            if (MEpi::PAIR) acc1 = __builtin_amdgcn_mfma_f32_16x16x32_bf16(b1[i], af[i], acc1, 0, 0, 0); }
        part[wid * 64 + lane] = acc0; if (MEpi::PAIR) part[512 + wid * 64 + lane] = acc1;
        __syncthreads();
        if (wid == 0) { f32x4 s0 = part[lane], s1 = {0.f, 0.f, 0.f, 0.f};
#pragma unroll
            for (int w = 1; w < 8; ++w) s0 = s0 + part[w * 64 + lane];
            if (MEpi::PAIR) { s1 = part[512 + lane];
#pragma unroll
                for (int w = 1; w < 8; ++w) s1 = s1 + part[512 + w * 64 + lane]; }
            E(s0, s1, task, lane, rsv); }
        __syncthreads();
    }
}
}

__device__ __forceinline__ void transpose_item(const float* W, int K, int N, bf16_t* WT, int k0, int n0, int out_row0, LAS float* scr, int lane, const float* gk = nullptr) {
    float wv_[32];
#pragma unroll
    for (int i = 0; i < 32; ++i) { const int kk = 2 * i + (lane >> 5); wv_[i] = W[(size_t)(k0 + kk) * N + n0 + (lane & 31)]; }
    if (gk) {
#pragma unroll
        for (int i = 0; i < 32; ++i) wv_[i] *= gk[k0 + 2 * i + (lane >> 5)]; }
#pragma unroll
    for (int i = 0; i < 32; ++i) { const int kk = 2 * i + (lane >> 5); scr[kk * 33 + (lane & 31)] = wv_[i]; }
    asm volatile("s_waitcnt lgkmcnt(0)" ::: "memory");
    const int c = lane & 7;
#pragma unroll
    for (int j = 0; j < 4; ++j) { const int n = (lane >> 3) + 8 * j; const LAS float* s = scr + (8 * c) * 33 + n;
        u32x4 o; o.x = pk2(s[0 * 33], s[1 * 33]); o.y = pk2(s[2 * 33], s[3 * 33]); o.z = pk2(s[4 * 33], s[5 * 33]); o.w = pk2(s[6 * 33], s[7 * 33]);
        *(u32x4*)(WT + (size_t)(out_row0 + n) * K + k0 + 8 * c) = o; }
    asm volatile("s_waitcnt lgkmcnt(0)" ::: "memory");
}
__device__ __forceinline__ void transpose_matrix(const float* W, int K, int N, bf16_t* WT, int mode, LAS float* scr, int gw, int ngw, int lane, const float* gk = nullptr) {
    const int nblk = N / 32, items = (K / 64) * nblk;
    for (int it = gw; it < items; it += ngw) { const int kb = it / nblk, nb = it % nblk, n0 = 32 * nb;
        const int orow = mode == 0 ? n0 : ((n0 / 128) * 256 + (n0 % 128) + (mode == 2 ? 128 : 0));
        transpose_item(W, K, N, WT, 64 * kb, n0, orow, scr, lane, gk); }
}

__device__ __forceinline__ void init_row(const float* src, float* hrow, bf16_t* hb, float* ssp, float* ssm, int lane) {
    float s = 0.f;
#pragma unroll
    for (int j = 0; j < 4; ++j) { const f32x4 v = *((const f32x4*)src + lane + 64 * j); s += (v.x * v.x + v.y * v.y) + (v.z * v.z + v.w * v.w);
        u32x2 o; o.x = pk2(v.x, v.y); o.y = pk2(v.z, v.w); *((u32x2*)hb + lane + 64 * j) = o; }
    s = wave_sum(s); if (lane < 16) ssp[lane] = lane == 0 ? s : 0.f;
    if (ssm) ssm[lane] = lane == 0 ? s : 0.f;
}
__device__ __forceinline__ void norm_row(const float* src, const float* g, bf16_t* yrow, float* hcopy, float* fout, int lane) {
    f32x4 v[4]; float s = 0.f;
#pragma unroll
    for (int j = 0; j < 4; ++j) { v[j] = *((const f32x4*)src + lane + 64 * j); s += (v[j].x * v[j].x + v[j].y * v[j].y) + (v[j].z * v[j].z + v[j].w * v[j].w); }
    const float rs = 1.0f / sqrtf(wave_sum(s) * (1.0f / DM) + 1e-6f);
#pragma unroll
    for (int j = 0; j < 4; ++j) {
        if (hcopy) *((f32x4*)hcopy + lane + 64 * j) = v[j];
        const f32x4 gv = *((const f32x4*)g + lane + 64 * j); const f32x4 y = v[j] * rs * gv;
        if (fout) *((f32x4*)fout + lane + 64 * j) = y;
        if (yrow) { u32x2 o; o.x = pk2(y.x, y.y); o.y = pk2(y.z, y.w); *((u32x2*)yrow + lane + 64 * j) = o; }
    }
}

namespace att {
constexpr int A_K = 0, A_V = 65536, A_LUT = 131072, A_SCR = 131072 + 2048, A_X = 0;
__device__ __forceinline__ int crow(int r, int hi) { return (r & 3) + 8 * (r >> 2) + 4 * hi; }
__device__ __forceinline__ s16x4 vtr(const LAS unsigned char* p) { typedef short v4i16_t __attribute__((ext_vector_type(4))); return __builtin_bit_cast(s16x4, __builtin_amdgcn_ds_read_tr16_b64_v4i16((LAS v4i16_t*)p)); }
#define ATT_SB() do {} while (0)
__device__ __forceinline__ void glds16(const void* gsrc, unsigned lds_dst) { unsigned keep;
    asm volatile("s_mov_b32 %0, m0\n\ts_mov_b32 m0, %2\n\ts_nop 0\n\tglobal_load_lds_dwordx4 %1, off\n\ts_mov_b32 m0, %0" : "=&s"(keep) : "v"(gsrc), "s"(lds_dst) : "memory"); }
#define ATT_WAITBAR(N) asm volatile("s_waitcnt vmcnt(" #N ") lgkmcnt(0)\n\ts_barrier" ::: "memory")
#define ATT_MIDBAR() asm volatile("s_waitcnt lgkmcnt(0)\n\ts_barrier" ::: "memory")
__device__ __forceinline__ float xhalf_max(float v) { auto rr = __builtin_amdgcn_permlane32_swap(__float_as_uint(v), __float_as_uint(v), false, false); return fmaxf(__uint_as_float(rr[0]), __uint_as_float(rr[1])); }
__device__ __forceinline__ float xhalf_sum(float v) { auto rr = __builtin_amdgcn_permlane32_swap(__float_as_uint(v), __float_as_uint(v), false, false); return __uint_as_float(rr[0]) + __uint_as_float(rr[1]); }
template <int XM> __device__ __forceinline__ float swz_xor(float v) { return __int_as_float(__builtin_amdgcn_ds_swizzle(__float_as_int(v), (XM << 10) | 0x1F)); }

__device__ __forceinline__ float max3a(float a, float b, float c) { float r; asm("v_max3_f32 %0, %1, %2, %3" : "=v"(r) : "v"(a), "v"(b), "v"(c)); return r; }
__device__ __forceinline__ void att_qs(bf16x8 (&pn)[4], f32x16 (&o)[4], f32x16& osum, f32x16& negm, const bf16x8 (&qf)[4], float& m_hat,
                                       const LAS unsigned char* kb, LAS float* scr, const LAS float* lut, int hi, int i32, bool near, int lutbase, bool first_tile) {
    __builtin_amdgcn_s_setprio(1);
    f32x16 c0, c1;
    bf16x8 kf[4];
#define ATT_KREAD(i) (*(const LAS bf16x8*)(kb + ((i) >> 1) * 2048 + ((i) & 1) * 512))
    kf[0] = ATT_KREAD(0); kf[1] = ATT_KREAD(1); kf[2] = ATT_KREAD(2); kf[3] = ATT_KREAD(3);
    __builtin_amdgcn_sched_barrier(0);
#pragma unroll
    for (int i = 0; i < 8; ++i) {
        if (i == 0) c0 = __builtin_amdgcn_mfma_f32_32x32x16_bf16(kf[0], qf[0], negm, 0, 0, 0);
        else if (i == 1) c1 = __builtin_amdgcn_mfma_f32_32x32x16_bf16(kf[1], qf[0], negm, 0, 0, 0);
        else if ((i & 1) == 0) c0 = __builtin_amdgcn_mfma_f32_32x32x16_bf16(kf[i & 3], qf[i >> 1], c0, 0, 0, 0);
        else c1 = __builtin_amdgcn_mfma_f32_32x32x16_bf16(kf[i & 3], qf[i >> 1], c1, 0, 0, 0);
        if (i + 4 < 8) kf[i & 3] = ATT_KREAD(i + 4);
        __builtin_amdgcn_sched_barrier(0);
    }
#undef ATT_KREAD
    if (near) {
#pragma unroll
        for (int r = 0; r < 16; ++r) { c0[r] += lut[lutbase + crow(r, hi)]; c1[r] += lut[lutbase + crow(r, hi) + 32]; }
    }
    if (first_tile) {
#pragma unroll
        for (int r = 0; r < 16; ++r) { if (crow(r, hi) >= NMETA) c0[r] = -INFINITY; c1[r] = -INFINITY; }
    }
    asm volatile("s_nop 15\n\ts_nop 7" : "+v"(c0), "+v"(c1));
    float rm;
    { float a = max3a(c0[0], c0[1], c0[2]), b = max3a(c1[0], c1[1], c1[2]);
#pragma unroll
      for (int r = 3; r < 15; r += 2) { a = max3a(a, c0[r], c0[r + 1]); b = max3a(b, c1[r], c1[r + 1]); }
      rm = max3a(a, b, c0[15]); rm = max3a(rm, c1[15], c1[15]); }
    rm = xhalf_max(rm);
    if (first_tile) {
        m_hat += rm;
#pragma unroll
        for (int r = 0; r < 16; ++r) { c0[r] -= rm; c1[r] -= rm; negm[r] = -m_hat; }
    } else if (__any(rm > 8.0f)) {
        const float dl = fmaxf(rm, 0.f); m_hat += dl; const float f = __builtin_amdgcn_exp2f(-dl);
#pragma unroll
        for (int r = 0; r < 16; ++r) { c0[r] -= dl; c1[r] -= dl; negm[r] = -m_hat; }
        if (hi == 0) scr[i32] = f;
        asm volatile("s_waitcnt lgkmcnt(0)" ::: "memory");
#pragma unroll
        for (int r = 0; r < 16; ++r) { const float fr_ = scr[crow(r, hi)]; osum[r] *= fr_;
#pragma unroll
            for (int d = 0; d < 4; ++d) o[d][r] *= fr_; }
    }
    unsigned paw[16];
#pragma unroll
    for (int g = 0; g < 8; ++g) { const int b = (4 * g) & 15;
        const float v0 = __builtin_amdgcn_exp2f(g < 4 ? c0[b] : c1[b]), v1 = __builtin_amdgcn_exp2f(g < 4 ? c0[b + 1] : c1[b + 1]);
        const float v2 = __builtin_amdgcn_exp2f(g < 4 ? c0[b + 2] : c1[b + 2]), v3 = __builtin_amdgcn_exp2f(g < 4 ? c0[b + 3] : c1[b + 3]);
        paw[2 * g] = pk2(v0, v1); paw[2 * g + 1] = pk2(v2, v3); }
#pragma unroll
    for (int k = 0; k < 4; ++k) { u32x4 w; w.x = paw[4 * k]; w.y = paw[4 * k + 1]; w.z = paw[4 * k + 2]; w.w = paw[4 * k + 3]; pn[k] = __builtin_bit_cast(bf16x8, w); }
    __builtin_amdgcn_s_setprio(0);
}
__device__ __forceinline__ void att_pv(const bf16x8 (&pp)[4], f32x16 (&o)[4], f32x16& osum, const LAS unsigned char* vb) {
    s16x4 vl[2][4], vh[2][4];
#define ATT_VREADK(ks) do { _Pragma("unroll") for (int d_ = 0; d_ < 4; ++d_) { vl[(ks) & 1][d_] = vtr(vb + d_ * 4096 + (ks) * 1024); vh[(ks) & 1][d_] = vtr(vb + d_ * 4096 + (ks) * 1024 + 512); } } while (0)
    const bf16x8 ones = (bf16x8){0x3F80, 0x3F80, 0x3F80, 0x3F80, 0x3F80, 0x3F80, 0x3F80, 0x3F80};
    ATT_VREADK(0);
#pragma unroll
    for (int ks = 0; ks < 4; ++ks) {
        if (ks + 1 < 4) ATT_VREADK(ks + 1);
        osum = __builtin_amdgcn_mfma_f32_32x32x16_bf16(pp[ks], ones, osum, 0, 0, 0);
#pragma unroll
        for (int d = 0; d < 4; ++d) { const int bk = ks & 1;
            const bf16x8 vf = (bf16x8){vl[bk][d][0], vl[bk][d][1], vl[bk][d][2], vl[bk][d][3], vh[bk][d][0], vh[bk][d][1], vh[bk][d][2], vh[bk][d][3]};
            o[d] = __builtin_amdgcn_mfma_f32_32x32x16_bf16(pp[ks], vf, o[d], 0, 0, 0); }
    }
#undef ATT_VREADK
}

__device__ __forceinline__ void attn_unit(LAS unsigned char* lds, const bf16_t* Qb, const unsigned char* Kimg, const unsigned char* Vimg, bf16_t* AO, int b, int h, int qpos0, int ntiles, int store_limit,
                                          const float* relb, const float* subg, float lam, float post) {
    const int tid = threadIdx.x, lane = tid & 63, i32 = lane & 31, hi = lane >> 5; const int wid = __builtin_amdgcn_readfirstlane(tid >> 6);
    const int c = wid >> 2, qg = wid & 3;
    const size_t rowbase = (size_t)b * LSEQ;
    LAS float* lut = (LAS float*)(lds + A_LUT);
    LAS float* scr = (LAS float*)(lds + A_SCR) + wid * 32;
    { const int rel = tid - 256; const int n = rel < 0 ? -rel : rel; int bk;
        if (n < 8) bk = n; else { const float lr = logf((float)n / 8.0f) / 2.772588722239781f; int lg = 8 + (int)(lr * 8.0f); bk = lg < 15 ? lg : 15; }
        if (rel > 0) bk += 16;
        lut[tid] = (relb[bk * 8 + h] - relb[15 * 8 + h]) * LOG2E; }
    const int qp_w = qpos0 + 32 * qg;
    const int qpos = qp_w + i32;
    bf16x8 qf[4];
    { const int qr = qpos < LSEQ ? qpos : LSEQ - 1; const bf16_t* qp = Qb + (rowbase + qr) * DM + h * 128 + c * 64 + 8 * hi;
#pragma unroll
      for (int d0 = 0; d0 < 4; ++d0) qf[d0] = *(const bf16x8*)(qp + 16 * d0); }
    const int ch_w = qp_w < NMETA ? 0 : 1 + (qp_w - NMETA) / 64;
    const int T_w = ch_w < ntiles - 1 ? ch_w : ntiles - 1;
    const unsigned char* kg0 = Kimg + (size_t)(b * 8 + h) * pg8::KV_BH_BYTES + wid * 1024 + lane * 16;
    const unsigned char* vg0 = Vimg + (size_t)(b * 8 + h) * pg8::KV_BH_BYTES + wid * 1024 + lane * 16;
#define TILE_POS(tt) ((tt) == 0 ? 0 : NMETA + 64 * ((tt) - 1))
    const unsigned lds0 = (unsigned)(uintptr_t)lds;
#define DMA_TILE(tt) do { const int t_ = (tt) < ntiles ? (tt) : ntiles - 1; const size_t kp_ = (size_t)t_ * 16384; const unsigned sl_ = (unsigned)(((tt) & 3) * 16384) + (unsigned)wid * 1024u; \
        const unsigned kd_ = (unsigned)__builtin_amdgcn_readfirstlane(lds0 + A_K + sl_), vd_ = (unsigned)__builtin_amdgcn_readfirstlane(lds0 + A_V + sl_); \
        glds16(kg0 + kp_, kd_); glds16(kg0 + kp_ + 8192, kd_ + 8192u); glds16(vg0 + kp_, vd_); glds16(vg0 + kp_ + 8192, vd_ + 8192u); } while (0)
    f32x16 o[4];
#pragma unroll
    for (int d = 0; d < 4; ++d)
#pragma unroll
        for (int r = 0; r < 16; ++r) o[d][r] = 0.f;
    bf16x8 pn[4];
#pragma unroll
    for (int k = 0; k < 4; ++k) pn[k] = (bf16x8){0, 0, 0, 0, 0, 0, 0, 0};
    f32x16 osum, negm;
#pragma unroll
    for (int r = 0; r < 16; ++r) { osum[r] = 0.f; negm[r] = 0.f; }
    float m_hat = 0.f;
    DMA_TILE(0); DMA_TILE(1);
    ATT_WAITBAR(4);
    const LAS unsigned char* kfb = lds + A_K + (8 * c + hi) * 1024 + i32 * 16;
    const LAS unsigned char* vfb = lds + A_V + ((lane >> 4) & 1) * 32 + (lane & 3) * 8 + (4 * hi + ((lane & 15) >> 2)) * 64;
#define ATT_COMMON(tt) \
        const int kp0_ = TILE_POS(tt); const bool near_ = (kp0_ + 63 - qp_w) >= -90; const int lb_ = kp0_ - qpos + 256; const LAS unsigned char* kb_ = kfb + ((tt) & 3) * 16384;
    if (c == 0) {
        for (int tt = 0; tt < ntiles; ++tt) {
            ATT_COMMON(tt)
            if (tt <= T_w) att_qs(pn, o, osum, negm, qf, m_hat, kb_, scr, lut, hi, i32, near_, lb_, tt == 0);
            DMA_TILE(tt + 2);
            if (tt <= T_w) att_pv(pn, o, osum, vfb + (tt & 3) * 16384);
            ATT_WAITBAR(4);
        }
    } else {
        for (int tt = 0; tt < ntiles; ++tt) {
            ATT_COMMON(tt)
            if (tt >= 1 && tt - 1 <= T_w) att_pv(pn, o, osum, vfb + ((tt - 1) & 3) * 16384);
            if (tt <= T_w) att_qs(pn, o, osum, negm, qf, m_hat, kb_, scr, lut, hi, i32, near_, lb_, tt == 0);
            DMA_TILE(tt + 2);
            ATT_WAITBAR(4);
        }
        if (ntiles - 1 <= T_w) att_pv(pn, o, osum, vfb + ((ntiles - 1) & 3) * 16384);
    }
    asm volatile("s_waitcnt vmcnt(0)" ::: "memory");
#undef ATT_COMMON
    __syncthreads();
    { const float num = (c == 0 ? 1.0f : -lam);
#pragma unroll
      for (int r = 0; r < 16; ++r) { const float fr_ = num / osum[r];
#pragma unroll
          for (int d = 0; d < 4; ++d) o[d][r] *= fr_; } }
    LAS float* X = (LAS float*)(lds + A_X) + qg * (32 * 128);
    if (c == 1) {
#pragma unroll
        for (int r = 0; r < 16; ++r)
#pragma unroll
            for (int d = 0; d < 4; ++d) X[crow(r, hi) * 128 + 32 * d + i32] = o[d][r];
    }
    __syncthreads();
    if (c == 0) {
        float sg[4];
#pragma unroll
        for (int d = 0; d < 4; ++d) sg[d] = subg[32 * d + i32] * post;
#pragma unroll
        for (int r = 0; r < 16; ++r) { const int qr = crow(r, hi); float ss = 0.f;
#pragma unroll
            for (int d = 0; d < 4; ++d) { o[d][r] += X[qr * 128 + 32 * d + i32]; ss += o[d][r] * o[d][r]; }
            ss += swz_xor<1>(ss); ss += swz_xor<2>(ss); ss += swz_xor<4>(ss); ss += swz_xor<8>(ss); ss += swz_xor<16>(ss);
            const float rs = 1.0f / sqrtf(ss * (1.0f / 128.0f) + 1e-5f);
            const int qp = qp_w + qr;
            if (qp < store_limit) { bf16_t* op = AO + (rowbase + qp) * DM + h * 128 + i32;
#pragma unroll
                for (int d = 0; d < 4; ++d) op[32 * d] = (bf16_t)f2bf(o[d][r] * rs * sg[d]); } }
    }
    __syncthreads();
#undef TILE_POS
#undef DMA_TILE
}
#undef ATT_SB
}

struct Args {
    const float* x; const float* meta; const float* norm_mix_g; const float* norm_ffn_g; const float* final_g; const float* relb;
    const float* pool_w; const float* pool_b; const float* pool_scale;
    const float* w_qkv; const float* w_o; const float* lq1; const float* lk1; const float* lq2; const float* lk2; const float* subg;
    const float* c_win; const float* c_bin; const float* c_dww; const float* c_dwb; const float* c_lng; const float* c_lnb; const float* c_wout; const float* c_bout;
    const float* f_wg; const float* f_wu; const float* f_wd;
    float* out; unsigned char* ws; int ph_lo, ph_hi;
};


__device__ __forceinline__ void ffn_up(LAS unsigned char* lds, const bf16_t* HB, const bf16_t* W, bf16_t* BIG, const float* ssp, const float* ssm) {
    { pg8::MEpiSwiGLU ME; ME.O = BIG; ME.ss = ssm; pg8::meta_gemm<DM>(lds, HB, DM, W, 176, 0, ME); }
    pg8::EpiSwiGLU E; E.O = BIG; E.ldo = FF; E.ss = ssp; pg8::run_gemm(lds, HB, DM, W, NGU, DM, 0, E); }
__device__ __forceinline__ void resid_gemm(LAS unsigned char* lds, const bf16_t* A, int lda, const bf16_t* W, int K, int grouped, float* H, bf16_t* HB, const float* bias, const float* scale, float* ssp, float* ssm) {
    { pg8::MEpiResid ME; ME.H = H; ME.bias = bias; ME.scale = scale; ME.HB = HB; ME.ss_out = ssm; if (K == 256) pg8::meta_gemm<256>(lds, A, lda, W, 64, grouped, ME); else if (K == DM) pg8::meta_gemm<DM>(lds, A, lda, W, 64, grouped, ME); else pg8::meta_gemm<FF>(lds, A, lda, W, 64, grouped, ME); }
    pg8::EpiResid E; E.H = H; E.bias = bias; E.scale = scale; E.HB = HB; E.ss_out = ssp; pg8::run_gemm(lds, A, lda, W, DM, K, grouped, E); }
__device__ __forceinline__ void pool_prep(LAS unsigned char* lds, const bf16_t* HB, const float* ssp, const float* ssm, const float* g, bf16_t* Z, int G, int tid) {
    const int C = (MROWS + G - 1) / G; const int r0 = (int)blockIdx.x * C; int r1 = r0 + C; if (r1 > MROWS) r1 = MROWS;
    LAS float* rst = (LAS float*)lds;
    for (int i = tid; i < C + 15; i += 512) { const int row = r0 - 15 + i; float v = 0.f;
        if (row >= 0 && row < r1) { const int pos = row % LSEQ; v = pos < NMETA ? rs64(ssm, pos) : rs16(ssp, row); }
        rst[i] = v; }
    __syncthreads();
    const int cgi = tid & 127, run = tid >> 7, win = 2 << (cgi >> 5);
    const int RL = (r1 - r0 + 3) >> 2; const int ra = r0 + run * RL; int rb = ra + RL; if (rb > r1) rb = r1;
    const f32x4 g0 = *(const f32x4*)(g + cgi * 8), g1 = *(const f32x4*)(g + cgi * 8 + 4);
    float sm[8];
#pragma unroll
    for (int e = 0; e < 8; ++e) sm[e] = 0.f;
#define LDY(dst, row_) do { const u32x4 v_ = *(const u32x4*)(HB + (size_t)(row_) * DM + cgi * 8); const float rs_ = rst[(row_) - r0 + 15]; \
        dst[0] = bflo(v_.x) * rs_; dst[1] = bfhi(v_.x) * rs_; dst[2] = bflo(v_.y) * rs_; dst[3] = bfhi(v_.y) * rs_; dst[4] = bflo(v_.z) * rs_; dst[5] = bfhi(v_.z) * rs_; dst[6] = bflo(v_.w) * rs_; dst[7] = bfhi(v_.w) * rs_; } while (0)
    if (ra < rb) { const int t = ra % LSEQ; const int np = (win - 1) < t ? (win - 1) : t;
        for (int j = 1; j <= np; ++j) { float y[8]; LDY(y, ra - j);
#pragma unroll
            for (int e = 0; e < 8; ++e) sm[e] += y[e]; } }
#pragma unroll 4
    for (int r = ra; r < rb; ++r) {
        const int t = r % LSEQ; float yn[8], yo[8];
        LDY(yn, r);
        const bool drop = (t + 1 >= win); const int ro = drop ? r - win + 1 : r;
        LDY(yo, ro);
        if (t == 0) {
#pragma unroll
            for (int e = 0; e < 8; ++e) sm[e] = 0.f; }
        const int cnt = (t + 1) < win ? (t + 1) : win; const float ic = 1.0f / (float)cnt;
        float o[8];
#pragma unroll
        for (int e = 0; e < 8; ++e) { sm[e] += yn[e]; o[e] = sm[e] * ic - yn[e]; if (drop) sm[e] -= yo[e]; }
        u32x4 w; w.x = pk2(o[0] * g0[0], o[1] * g0[1]); w.y = pk2(o[2] * g0[2], o[3] * g0[3]); w.z = pk2(o[4] * g1[0], o[5] * g1[1]); w.w = pk2(o[6] * g1[2], o[7] * g1[3]);
        *(u32x4*)(Z + (size_t)r * DM + cgi * 8) = w;
    }
#undef LDY
    __syncthreads();
}

__device__ __forceinline__ void grid_bar(unsigned* bar, unsigned target) {
    __syncthreads();
    if (threadIdx.x == 0) {
        __builtin_amdgcn_fence(__ATOMIC_RELEASE, "agent");
        asm volatile("s_waitcnt vmcnt(0)" ::: "memory");
        __hip_atomic_fetch_add(bar, 1u, __ATOMIC_RELAXED, __HIP_MEMORY_SCOPE_AGENT);
        while (__hip_atomic_load(bar, __ATOMIC_RELAXED, __HIP_MEMORY_SCOPE_AGENT) < target) __builtin_amdgcn_s_sleep(1);
        __builtin_amdgcn_fence(__ATOMIC_ACQUIRE, "agent");
        asm volatile("s_waitcnt vmcnt(0)" ::: "memory");
    }
    __syncthreads();
}
__device__ __forceinline__ unsigned xcc_id() { return (unsigned)__builtin_amdgcn_s_getreg((3 << 11) | 20) & 0xFu; }
__device__ __forceinline__ void grid_bar2(unsigned* ctl, const LAS unsigned* lc, unsigned r) {
    __syncthreads();
    if (threadIdx.x == 0) {
        const unsigned x = lc[0], n_x = lc[1], nx = lc[2];
        if (nx < 2u) __builtin_amdgcn_fence(__ATOMIC_RELEASE, "agent");
        asm volatile("s_waitcnt vmcnt(0)" ::: "memory");
        const unsigned a_ = __hip_atomic_fetch_add(ctl + 64 * (17 + x), 1u, __ATOMIC_RELAXED, __HIP_MEMORY_SCOPE_AGENT);
        if (a_ + 1u == r * n_x) {
            __builtin_amdgcn_fence(__ATOMIC_RELEASE, "agent");
            asm volatile("s_waitcnt vmcnt(0)" ::: "memory");
            __hip_atomic_fetch_add(ctl, 1u, __ATOMIC_RELAXED, __HIP_MEMORY_SCOPE_AGENT);
            while (__hip_atomic_load(ctl, __ATOMIC_RELAXED, __HIP_MEMORY_SCOPE_AGENT) < r * nx) __builtin_amdgcn_s_sleep(1);
            __hip_atomic_store(ctl + 64 * (33 + x), r, __ATOMIC_RELAXED, __HIP_MEMORY_SCOPE_AGENT);
        } else {
            while (__hip_atomic_load(ctl + 64 * (33 + x), __ATOMIC_RELAXED, __HIP_MEMORY_SCOPE_AGENT) < r) __builtin_amdgcn_s_sleep(1);
        }
        __builtin_amdgcn_fence(__ATOMIC_ACQUIRE, "agent");
        asm volatile("s_waitcnt vmcnt(0)" ::: "memory");
    }
    __syncthreads();
}
__global__ void __launch_bounds__(512, 2) fwd_kernel(Args a) {
    extern __shared__ __attribute__((aligned(16))) unsigned char shm_raw[];
    LAS unsigned char* lds = (LAS unsigned char*)shm_raw;
    cg::grid_group grid = cg::this_grid();
    const int tid = threadIdx.x, lane = tid & 63, wave = tid >> 6;
    const int G = (int)gridDim.x, gw = (int)blockIdx.x * 8 + wave, NGW = G * 8;
    float* H = (float*)(a.ws + WS_H); bf16_t* Y = (bf16_t*)(a.ws + WS_Y); bf16_t* BIG = (bf16_t*)(a.ws + WS_BIG); bf16_t* Z = (bf16_t*)a.out;
    bf16_t* Wgu = (bf16_t*)(a.ws + WS_WGU); bf16_t* Wd = (bf16_t*)(a.ws + WS_WD); bf16_t* Wqkv = (bf16_t*)(a.ws + WS_WQKV); bf16_t* Wo = (bf16_t*)(a.ws + WS_WO);
    unsigned char* KIMG = a.ws + WS_BIG + (size_t)MP * DM * 2; unsigned char* VIMG = KIMG + (size_t)MP * DM * 2;
    unsigned* BAR = (unsigned*)(a.ws + WS_CTL);
    LAS unsigned* LC = (LAS unsigned*)(lds + LDS_CTL);
    if (threadIdx.x == 0) { const unsigned x_ = xcc_id(); LC[0] = x_; __hip_atomic_fetch_add(BAR + 64 * (1 + x_), 1u, __ATOMIC_RELAXED, __HIP_MEMORY_SCOPE_AGENT); }
    float* SSP = (float*)(a.ws + WS_SS); float* SSM = (float*)(a.ws + WS_SSM);
    bf16_t* Win = (bf16_t*)(a.ws + WS_WIN); bf16_t* Wout = (bf16_t*)(a.ws + WS_WOUT); bf16_t* Wp = (bf16_t*)(a.ws + WS_WP);
    const int lo = a.ph_lo, hi_ = a.ph_hi;
    int ph = 0;
    if (lo < 0) grid.sync();
#define PH_BEGIN if (ph >= lo && ph < hi_) {
#define PH_END } ++ph; if (ph > lo && ph < hi_) { if (ph == 1) { grid_bar(BAR + 64 * 49, (unsigned)G); if (threadIdx.x == 0) { const unsigned x_ = LC[0]; unsigned nx_ = 0; \
        for (int j_ = 0; j_ < 16; ++j_) nx_ += __hip_atomic_load(BAR + 64 * (1 + j_), __ATOMIC_RELAXED, __HIP_MEMORY_SCOPE_AGENT) != 0u; \
        LC[1] = __hip_atomic_load(BAR + 64 * (1 + x_), __ATOMIC_RELAXED, __HIP_MEMORY_SCOPE_AGENT); LC[2] = nx_; } } else grid_bar2(BAR, LC, (unsigned)(ph - 1)); }

    PH_BEGIN
    {
        LAS float* scr = (LAS float*)(lds + wave * 8448);
        for (int l = 0; l < 4; ++l) {
            transpose_matrix(a.f_wg + (size_t)l * DM * FF, DM, FF, Wgu + (size_t)l * NGU * DM, 1, scr, gw, NGW, lane, a.norm_ffn_g + l * DM);
            transpose_matrix(a.f_wu + (size_t)l * DM * FF, DM, FF, Wgu + (size_t)l * NGU * DM, 2, scr, gw, NGW, lane, a.norm_ffn_g + l * DM);
            transpose_matrix(a.f_wd + (size_t)l * FF * DM, FF, DM, Wd + (size_t)l * DM * FF, 0, scr, gw, NGW, lane);
        }
        transpose_matrix(a.w_qkv, DM, NQKV, Wqkv, 0, scr, gw, NGW, lane, a.norm_mix_g + 1 * DM);
        transpose_matrix(a.w_o, DM, DM, Wo, 0, scr, gw, NGW, lane);
        {   const int nblk = 2048 / 32, items = (DM / 64) * nblk;
            for (int it = gw; it < items; it += NGW) { const int kb = it / nblk, nb = it % nblk, n0 = 32 * nb; const int half = n0 >= DM, j0 = n0 - half * DM;
                transpose_item(a.c_win, DM, 2048, Win, 64 * kb, n0, (j0 / 128) * 256 + (j0 % 128) + half * 128, scr, lane, a.norm_mix_g + 2 * DM); } }
        transpose_matrix(a.c_wout, DM, DM, Wout, 0, scr, gw, NGW, lane);
        for (int jg = 0; jg < 8; ++jg) transpose_matrix(a.pool_w + (size_t)jg * 256 * 256, 256, 256, Wp + (size_t)jg * 256 * 256, 0, scr, gw, NGW, lane);
#pragma unroll 2
        for (int r = gw; r < MROWS; r += NGW) { const int b = r / LSEQ, p = r % LSEQ;
            const float* src = p < NMETA ? a.meta + (size_t)p * DM : a.x + ((size_t)b * SEQ + (p - NMETA)) * DM;
            init_row(src, H + (size_t)r * DM, Y + (size_t)r * DM, SSP + (size_t)r * 16, r < NMETA ? SSM + r * 64 : nullptr, lane); }
        for (int i = (int)blockIdx.x * 512 + tid; i < (MP - MROWS) * DM / 8; i += G * 512) { const u32x4 z = {0u, 0u, 0u, 0u};
            *((u32x4*)(Y + (size_t)MROWS * DM) + i) = z; *((u32x4*)(Z + (size_t)MROWS * DM) + i) = z; }
    }
    PH_END

    PH_BEGIN pool_prep(lds, Y, SSP, SSM, a.norm_mix_g + 0 * DM, Z, G, tid); PH_END
    PH_BEGIN resid_gemm(lds, Z, DM, Wp, 256, 1, H, Y, a.pool_b, a.pool_scale, SSP, SSM); PH_END
    PH_BEGIN ffn_up(lds, Y, Wgu + (size_t)0 * NGU * DM, BIG, SSP, SSM); PH_END
    PH_BEGIN resid_gemm(lds, BIG, FF, Wd + (size_t)0 * DM * FF, FF, 0, H, Y, nullptr, nullptr, SSP, SSM); PH_END
    PH_BEGIN { { pg8::MEpiQKV ME; ME.Q = BIG; ME.Kimg = KIMG; ME.Vimg = VIMG; ME.ss = SSM; pg8::meta_gemm<DM>(lds, Y, DM, Wqkv, 192, 0, ME); } pg8::EpiQKV E; E.Q = BIG; E.Kimg = KIMG; E.Vimg = VIMG; E.ss = SSP; pg8::run_gemm(lds, Y, DM, Wqkv, NQKV, DM, 0, E); } PH_END
    PH_BEGIN
    {
        const float lam_init = 0.8f - 0.6f * expf(-0.3f * 1.0f);
        float d1 = a.lq1[lane] * a.lk1[lane], d2 = a.lq2[lane] * a.lk2[lane];
        d1 = wave_sum(d1); d2 = wave_sum(d2);
        const float lam = expf(d1) - expf(d2) + lam_init;
        const int NU = 2048 + 16;
        for (int i = 0;; ++i) {
            const int v = (i & 1) ? (G - 1 - (int)blockIdx.x) : (int)blockIdx.x;
            const int p = i * G + v;
            if (i * G >= NU) break;
            if (p >= NU) continue;
            int bh, qpos0, ntiles, slim;
            if (p < 2048) { const int jq = 127 - (p >> 4); bh = p & 15; qpos0 = NMETA + 128 * jq; ntiles = 2 * jq + 3; slim = LSEQ; }
            else { bh = p - 2048; qpos0 = 0; ntiles = 1; slim = NMETA; }
            att::attn_unit(lds, BIG, KIMG, VIMG, Z, bh >> 3, bh & 7, qpos0, ntiles, slim, a.relb, a.subg, lam, 1.0f - lam_init);
        }
    }
    PH_END
    PH_BEGIN resid_gemm(lds, Z, DM, Wo, DM, 0, H, Y, nullptr, nullptr, SSP, SSM); PH_END
    PH_BEGIN ffn_up(lds, Y, Wgu + (size_t)1 * NGU * DM, BIG, SSP, SSM); PH_END
    PH_BEGIN resid_gemm(lds, BIG, FF, Wd + (size_t)1 * DM * FF, FF, 0, H, Y, nullptr, nullptr, SSP, SSM); PH_END
    PH_BEGIN { { pg8::MEpiGLU ME; ME.O = BIG; ME.bias = a.c_bin; ME.ss = SSM; pg8::meta_gemm<DM>(lds, Y, DM, Win, 64, 0, ME); } pg8::EpiGLU E; E.O = BIG; E.bias = a.c_bin; E.ss = SSP; pg8::run_gemm(lds, Y, DM, Win, 2048, DM, 0, E); } PH_END
    PH_BEGIN
    {
        const int c2 = 2 * tid;
        float wv[31][2];
#pragma unroll
        for (int j = 0; j < 31; ++j) { wv[j][0] = a.c_dww[j * DM + c2]; wv[j][1] = a.c_dww[j * DM + c2 + 1]; }
        const float db0 = a.c_dwb[c2], db1 = a.c_dwb[c2 + 1];
        const int TPB = (LSEQ + 15) / 16, NT_ = BATCH * TPB;
        for (int tile = (int)blockIdx.x; tile < NT_; tile += G) {
            const int b = tile / TPB, t0 = (tile % TPB) * 16; const size_t rb = (size_t)b * LSEQ;
            {
                u32x4 sv[12];
#pragma unroll
                for (int k = 0; k < 12; ++k) { const int gi = tid + 512 * k, rr = gi >> 7, cc = gi & 127; const int t = t0 - 30 + rr;
                    sv[k] = (u32x4){0u, 0u, 0u, 0u}; if (gi < 46 * 128 && t >= 0 && t < LSEQ) sv[k] = *(const u32x4*)(BIG + (rb + t) * DM + cc * 8); }
#pragma unroll
                for (int k = 0; k < 12; ++k) { const int gi = tid + 512 * k, rr = gi >> 7, cc = gi & 127; if (gi < 46 * 128) *(LAS u32x4*)(lds + rr * 2048 + cc * 16) = sv[k]; }
            }
            __syncthreads();
            float acc[16][2];
#pragma unroll
            for (int r = 0; r < 16; ++r) { acc[r][0] = db0; acc[r][1] = db1; }
#pragma unroll
            for (int j = 0; j < 31; ++j) {
#pragma unroll
                for (int r = 0; r < 16; ++r) { const unsigned w = *(const LAS unsigned*)(lds + (r + j) * 2048 + tid * 4);
                    acc[r][0] += wv[j][0] * bflo(w); acc[r][1] += wv[j][1] * bfhi(w); } }
            __syncthreads();
#pragma unroll
            for (int r = 0; r < 16; ++r) { f32x2_t v = {acc[r][0], acc[r][1]}; *(LAS f32x2_t*)(lds + r * 4096 + tid * 8) = v; }
            __syncthreads();
            for (int rr = 0; rr < 2; ++rr) { const int r = wave * 2 + rr, t = t0 + r;
                if (t < LSEQ) {
                    f32x4 v[4]; float s = 0.f;
#pragma unroll
                    for (int j = 0; j < 4; ++j) { v[j] = *(const LAS f32x4*)(lds + r * 4096 + (lane + 64 * j) * 16); s += (v[j].x + v[j].y) + (v[j].z + v[j].w); }
                    const float mu = wave_sum(s) * (1.0f / DM); float s2 = 0.f;
#pragma unroll
                    for (int j = 0; j < 4; ++j) { v[j] = v[j] - mu; s2 += (v[j].x * v[j].x + v[j].y * v[j].y) + (v[j].z * v[j].z + v[j].w * v[j].w); }
                    const float rstd = 1.0f / sqrtf(wave_sum(s2) * (1.0f / DM) + 1e-5f);
#pragma unroll
                    for (int j = 0; j < 4; ++j) { const f32x4 gv = *((const f32x4*)a.c_lng + lane + 64 * j), bv = *((const f32x4*)a.c_lnb + lane + 64 * j);
                        f32x4 y = v[j] * rstd * gv + bv; y.x *= sigmoidf_(y.x); y.y *= sigmoidf_(y.y); y.z *= sigmoidf_(y.z); y.w *= sigmoidf_(y.w);
                        u32x2 o; o.x = pk2(y.x, y.y); o.y = pk2(y.z, y.w); *((u32x2*)(Z + (rb + t) * DM) + lane + 64 * j) = o; }
                } }
            __syncthreads();
        }
    }
    PH_END
    PH_BEGIN resid_gemm(lds, Z, DM, Wout, DM, 0, H, Y, a.c_bout, nullptr, SSP, SSM); PH_END
    PH_BEGIN ffn_up(lds, Y, Wgu + (size_t)2 * NGU * DM, BIG, SSP, SSM); PH_END
    PH_BEGIN resid_gemm(lds, BIG, FF, Wd + (size_t)2 * DM * FF, FF, 0, H, Y, nullptr, nullptr, SSP, SSM); PH_END
    PH_BEGIN pool_prep(lds, Y, SSP, SSM, a.norm_mix_g + 3 * DM, Z, G, tid); PH_END
    PH_BEGIN resid_gemm(lds, Z, DM, Wp + (size_t)4 * 256 * 256, 256, 1, H, Y, a.pool_b + DM, a.pool_scale + DM, SSP, SSM); PH_END
    PH_BEGIN ffn_up(lds, Y, Wgu + (size_t)3 * NGU * DM, BIG, SSP, SSM); PH_END
    PH_BEGIN resid_gemm(lds, BIG, FF, Wd + (size_t)3 * DM * FF, FF, 0, H, Y, nullptr, nullptr, SSP, SSM); PH_END
    PH_BEGIN
    for (int r = gw; r < BATCH * SEQ; r += NGW) { const int b = r / SEQ, t = r % SEQ;
        const bf16_t* hp = Y + ((size_t)b * LSEQ + NMETA + t) * DM; f32x4 v[4]; float sq = 0.f;
#pragma unroll
        for (int j = 0; j < 4; ++j) { const u32x2 w = *((const u32x2*)hp + lane + 64 * j); v[j] = (f32x4){bflo(w.x), bfhi(w.x), bflo(w.y), bfhi(w.y)}; sq += (v[j].x * v[j].x + v[j].y * v[j].y) + (v[j].z * v[j].z + v[j].w * v[j].w); }
        const float rs = 1.0f / sqrtf(wave_sum(sq) * (1.0f / DM) + 1e-6f);
#pragma unroll
        for (int j = 0; j < 4; ++j) { const f32x4 gv = *((const f32x4*)a.final_g + lane + 64 * j); *((f32x4*)(a.out + (size_t)r * DM) + lane + 64 * j) = v[j] * rs * gv; } }
    PH_END
#undef PH_BEGIN
#undef PH_END
}
constexpr int N_PHASES = 20;

#ifndef MK_MULTI
#define MK_MULTI 0
#endif

extern "C" void kernel_launch(void* const* d_in, const int* in_sizes, int n_in, void* d_out, int out_size, void* d_ws, size_t ws_size, hipStream_t stream) {
    static int grid = 0;
    if (grid == 0) {
        if (n_in != 27 || ws_size < WS_END) { fprintf(stderr, "kernel_launch: unexpected n_in %d / ws_size %zu (need %zu)\n", n_in, ws_size, (size_t)WS_END); grid = -1; return; }
        int dev = 0, cus = 0, per_cu = 0;
        hipGetDevice(&dev); hipDeviceGetAttribute(&cus, hipDeviceAttributeMultiprocessorCount, dev);
        if (hipFuncSetAttribute((const void*)fwd_kernel, hipFuncAttributeMaxDynamicSharedMemorySize, LDS_BYTES) != hipSuccess) { fprintf(stderr, "kernel_launch: hipFuncSetAttribute failed\n"); grid = -1; return; }
        if (hipOccupancyMaxActiveBlocksPerMultiprocessor(&per_cu, (const void*)fwd_kernel, 512, LDS_BYTES) != hipSuccess || per_cu < 1) { fprintf(stderr, "kernel_launch: occupancy query gave %d\n", per_cu); per_cu = 1; }
        (void)hipGetLastError();
        grid = cus * per_cu;
        fprintf(stderr, "kernel_launch: grid %d (%d CUs x %d)\n", grid, cus, per_cu);
    }
    if (grid < 0) return;
    Args a{};
    const float** f = (const float**)&a;
    for (int i = 0; i < 27; ++i) f[i] = (const float*)d_in[i];
    a.out = (float*)d_out; a.ws = (unsigned char*)d_ws;
#if MK_MULTI
    for (int p = 0; p < N_PHASES; ++p) { a.ph_lo = p; a.ph_hi = p + 1; void* args[] = {&a};
        hipError_t e = hipLaunchCooperativeKernel((const void*)fwd_kernel, dim3(grid), dim3(512), args, LDS_BYTES, stream);
        if (e != hipSuccess) { fprintf(stderr, "launch %d failed: %s\n", p, hipGetErrorString(e)); break; } }
#else
    if (hipMemsetAsync((char*)d_ws + WS_CTL, 0, 16384, stream) != hipSuccess) { fprintf(stderr, "kernel_launch: memset of the barrier word failed\n"); return; }
    a.ph_lo = 0; a.ph_hi = N_PHASES; void* args[] = {&a};
    hipError_t e = hipLaunchCooperativeKernel((const void*)fwd_kernel, dim3(grid), dim3(512), args, LDS_BYTES, stream);
    if (e != hipSuccess) fprintf(stderr, "cooperative launch failed: %s (grid %d)\n", hipGetErrorString(e), grid);
#endif
}
```

```cpp
#include <hip/hip_runtime.h>
#include <hip/hip_cooperative_groups.h>
#include <cstdio>
#include <cstdint>
namespace cg = cooperative_groups;

#define LAS __attribute__((address_space(3)))
typedef unsigned short bf16_t;
typedef short bf16x8 __attribute__((ext_vector_type(8)));
typedef short s16x4 __attribute__((ext_vector_type(4)));
typedef float f32x4 __attribute__((ext_vector_type(4)));
typedef float f32x16 __attribute__((ext_vector_type(16)));
typedef unsigned u32x4 __attribute__((ext_vector_type(4)));
typedef unsigned u32x2 __attribute__((ext_vector_type(2)));
typedef float f32x2_t __attribute__((ext_vector_type(2)));
typedef __bf16 bf16x2_t __attribute__((ext_vector_type(2)));

constexpr int DM = 1024, BATCH = 2, SEQ = 16384, NMETA = 16, LSEQ = SEQ + NMETA;
constexpr int MROWS = BATCH * LSEQ;
constexpr int MP = 33024;
constexpr int FF = 2816, NGU = 2 * FF;
constexpr int NQKV = 3 * DM;
constexpr float LOG2E = 1.4426950408889634f;
constexpr float QSCALE = 0.125f * LOG2E;

constexpr size_t SZ_H = (size_t)MP * DM * 4, SZ_Y = (size_t)MP * DM * 2, SZ_BIG = (size_t)MP * NQKV * 2;
constexpr size_t WS_H = 0, WS_Y = WS_H + SZ_H, WS_BIG = WS_Y + SZ_Y, WS_W = WS_BIG + SZ_BIG;
constexpr size_t SZ_WGU = (size_t)NGU * DM * 2, SZ_WD = (size_t)DM * FF * 2, SZ_SQ = (size_t)DM * DM * 2;
constexpr size_t WS_WGU = WS_W, WS_WD = WS_WGU + 4 * SZ_WGU, WS_WQKV = WS_WD + 4 * SZ_WD, WS_WO = WS_WQKV + 3 * SZ_SQ,
                 WS_WIN = WS_WO + SZ_SQ, WS_WOUT = WS_WIN + 2 * SZ_SQ, WS_WP = WS_WOUT + SZ_SQ, WS_SS = WS_WP + 2 * 4 * 256 * 256 * 2, WS_SSM = WS_SS + (size_t)MP * 16 * 4, WS_CTL = WS_SSM + 16 * 64 * 4, WS_END = WS_CTL + 16384;

constexpr int LDS_CTL = 131072 + 4096;
constexpr int LDS_BYTES = LDS_CTL + 64;

__device__ __forceinline__ unsigned f2bf(float f) { unsigned u = __builtin_bit_cast(unsigned, f); return (u + 0x7fffu + ((u >> 16) & 1u)) >> 16; }
__device__ __forceinline__ unsigned pk2(float lo, float hi) { f32x2_t v = {lo, hi}; bf16x2_t b = __builtin_convertvector(v, bf16x2_t); return __builtin_bit_cast(unsigned, b); }
__device__ __forceinline__ float bflo(unsigned w) { return __builtin_bit_cast(float, w << 16); }
__device__ __forceinline__ float bfhi(unsigned w) { return __builtin_bit_cast(float, w & 0xffff0000u); }
__device__ __forceinline__ float wave_sum(float v) {
#pragma unroll
    for (int o = 1; o < 64; o <<= 1) v += __shfl_xor(v, o);
    return v;
}
__device__ __forceinline__ float sigmoidf_(float x) { return __builtin_amdgcn_rcpf(1.0f + __expf(-x)); }
__device__ __forceinline__ float sum16(const float* p) { const f32x4 a = *(const f32x4*)p, b = *(const f32x4*)(p + 4), c = *(const f32x4*)(p + 8), d = *(const f32x4*)(p + 12); const f32x4 t = (a + b) + (c + d); return (t[0] + t[1]) + (t[2] + t[3]); }
__device__ __forceinline__ float rs16(const float* ssp, int row) { return 1.0f / sqrtf(sum16(ssp + (size_t)row * 16) * (1.0f / DM) + 1e-6f); }
__device__ __forceinline__ float rs64(const float* ssm, int r) { const float* p = ssm + r * 64; return 1.0f / sqrtf(((sum16(p) + sum16(p + 16)) + (sum16(p + 32) + sum16(p + 48))) * (1.0f / DM) + 1e-6f); }

namespace pg8 {
constexpr int BM = 256, BK = 64, HALF = 128, HTB = HALF * BK * 2, STAGE_BYTES = 8 * HTB, NXCD = 8, WGM = 8;
__host__ __device__ __forceinline__ int lds_byte(int r, int c) { const int st = (r >> 4) * 2 + (c >> 5), rr = r & 15, cc = c & 31, ob = rr * 64 + cc * 2; return st * 1024 + (ob ^ (((ob >> 9) & 1) << 5)); }
__host__ __device__ __forceinline__ void stage_rc(int b, int& R, int& C) { const int st = b / 1024, sb = b % 1024, swz = sb ^ (((sb >> 9) & 1) << 5); R = (st >> 1) * 16 + swz / 64; C = (st & 1) * 32 + (swz % 64) / 2; }
__host__ __device__ __forceinline__ int perm32(int rho) { const int n = rho >> 4, i = rho & 15; return 8 * (i >> 2) + 4 * n + (i & 3); }

struct Unit { int pm, pn; };
__device__ __forceinline__ int rowstart(int pm) { return pm * 256 + 16 * ((pm >> 6) + 1); }
struct Gemm { const bf16_t* A; const bf16_t* Bt; int M, N, K, lda, grouped; };

struct StaticOrder {
    int nM, nN, nwg, G, c;
    __device__ void init(int M, int N, int G_, int c_) { nM = M / BM; nN = N / BM; nwg = nM * nN; G = G_; c = c_; }
    __device__ bool next(int i, Unit& u) const {
        const long L = (long)i * G + c; if (L >= nwg) return false;
        int wgid = (int)L; { const int q = nwg / NXCD, r = nwg % NXCD, xcd = wgid % NXCD, off = wgid / NXCD; wgid = (xcd < r ? xcd * (q + 1) : r * (q + 1) + (xcd - r) * q) + off; }
        const int nig = WGM * nN, gid = wgid / nig, fm = gid * WGM, gsz = (nM - fm) < WGM ? (nM - fm) : WGM;
        u.pm = fm + ((wgid % nig) % gsz); u.pn = (wgid % nig) / gsz; return true;
    }
};

template <class Epi>
__device__ __forceinline__ void gemm_phase(LAS unsigned char* lds, const Gemm g, const StaticOrder& S, const Epi& E) {
    const int tid = threadIdx.x, wid = __builtin_amdgcn_readfirstlane(tid >> 6), lane = tid & 63, wr = wid >> 2, wc = wid & 3, fr = lane & 15, fq = lane >> 4;
    const int K = g.K, nt = K / BK;
    unsigned voffA[2], voffB[2];
#pragma unroll
    for (int i = 0; i < 2; ++i) { int R, C; stage_rc(tid * 16 + i * 8192, R, C); const int Rb = Epi::PERM ? ((R & ~31) + perm32(R & 31)) : R;
        voffA[i] = (unsigned)(R * g.lda + C) * 2u; voffB[i] = (unsigned)(Rb * K + C) * 2u; }
    const size_t kstep = (size_t)(BK * 2);
    const size_t hstepA = (size_t)HALF * g.lda * 2, hstepB = (size_t)HALF * K * 2;
    const size_t rstepA = (size_t)g.lda * 2, tstepB = 2 * hstepB;
    const size_t gstepA = g.grouped ? (size_t)K * 2 : 0;
    const unsigned ldsw = (unsigned)wid * 1024u;
    const int aoff = lds_byte(wr * 64 + fr, fq * 8), boff = lds_byte(wc * 32 + fr, fq * 8);
#define PG8_SA(b, h) (((b) * 2 + (h)) * HTB)
#define PG8_SB(b, h) ((4 + (b) * 2 + (h)) * HTB)
#define PG8_STAGE(bufoff, gbase, voff) do { _Pragma("unroll") for (int _i = 0; _i < 2; ++_i) \
        __builtin_amdgcn_global_load_lds((const unsigned*)((const char*)(gbase) + (voff)[_i]), (LAS unsigned*)(lds + (bufoff) + ldsw + _i * 8192), 16, 0, 0); } while (0)
#define PG8_LDA(dst, b, h) do { _Pragma("unroll") for (int m = 0; m < 4; ++m) _Pragma("unroll") for (int k = 0; k < 2; ++k) dst[m][k] = *(const LAS bf16x8*)(lds + PG8_SA(b, h) + aoff + m * 2048 + k * 1024); } while (0)
#define PG8_LDB(dst, b, h) do { _Pragma("unroll") for (int n = 0; n < 2; ++n) _Pragma("unroll") for (int k = 0; k < 2; ++k) dst[n][k] = *(const LAS bf16x8*)(lds + PG8_SB(b, h) + boff + n * 2048 + k * 1024); } while (0)
#define PG8_MMA(ai, bj, At, Bt) do { __builtin_amdgcn_s_setprio(1); _Pragma("unroll") for (int m = 0; m < 4; ++m) _Pragma("unroll") for (int n = 0; n < 2; ++n) _Pragma("unroll") for (int k = 0; k < 2; ++k) \
        acc[ai][bj][m][n] = __builtin_amdgcn_mfma_f32_16x16x32_bf16(Bt[n][k], At[m][k], acc[ai][bj][m][n], 0, 0, 0); __builtin_amdgcn_s_setprio(0); } while (0)
#define PG8_WAIT_V(n) asm volatile("s_waitcnt vmcnt(" #n ")" ::: "memory")
#define PG8_WAIT_L(n) asm volatile("s_waitcnt lgkmcnt(" #n ")" ::: "memory")
#define PG8_BAR __builtin_amdgcn_s_barrier()
#define PG8_SCHED __builtin_amdgcn_sched_barrier(0)
    Unit cur, nxt; int ui = 0;
    if (!S.next(0, cur)) return;
    f32x4 acc[2][2][4][2];
#pragma unroll
    for (int a = 0; a < 2; ++a)
#pragma unroll
        for (int b = 0; b < 2; ++b)
#pragma unroll
            for (int m = 0; m < 4; ++m)
#pragma unroll
                for (int n = 0; n < 2; ++n) acc[a][b][m][n] = (f32x4){0.f, 0.f, 0.f, 0.f};
    bf16x8 At[4][2], B0[2][2], B1[2][2];
    const char* cA = (const char*)g.A + (size_t)rowstart(cur.pm) * rstepA + (size_t)cur.pn * gstepA; const char* cB = (const char*)g.Bt + (size_t)cur.pn * tstepB;
    PG8_STAGE(PG8_SB(0, 0), cB, voffB); PG8_STAGE(PG8_SB(0, 1), cB + hstepB, voffB); PG8_STAGE(PG8_SA(0, 0), cA, voffA); PG8_STAGE(PG8_SA(0, 1), cA + hstepA, voffA);
    if (wr == 1) PG8_BAR;
    PG8_WAIT_V(2); PG8_BAR;
    PG8_STAGE(PG8_SB(1, 0), cB + kstep, voffB); PG8_STAGE(PG8_SA(1, 0), cA + kstep, voffA); PG8_STAGE(PG8_SB(1, 1), cB + hstepB + kstep, voffB);
    PG8_WAIT_V(6); PG8_BAR;
    for (;;) {
        const bool has_next = S.next(ui + 1, nxt);
        const char* nA = has_next ? (const char*)g.A + (size_t)rowstart(nxt.pm) * rstepA + (size_t)nxt.pn * gstepA : cA; const char* nB = has_next ? (const char*)g.Bt + (size_t)nxt.pn * tstepB : cB;
        for (int t = 0; t < nt; t += 2) {
            const bool last = (t == nt - 2);
            const char* a1 = cA + (size_t)(t + 1) * kstep;
            const char* a2 = last ? nA : cA + (size_t)(t + 2) * kstep; const char* b2 = last ? nB : cB + (size_t)(t + 2) * kstep;
            const char* a3 = a2 + kstep; const char* b3 = b2 + kstep;
            PG8_LDB(B0, 0, 0); PG8_LDB(B1, 0, 1); PG8_SCHED; PG8_LDA(At, 0, 0); PG8_STAGE(PG8_SA(1, 1), a1 + hstepA, voffA);
            PG8_WAIT_V(8); PG8_WAIT_L(0); PG8_BAR; PG8_MMA(0, 0, At, B0); PG8_MMA(0, 1, At, B1); PG8_BAR; PG8_SCHED;
            PG8_LDA(At, 0, 1); PG8_STAGE(PG8_SB(0, 0), b2, voffB); PG8_STAGE(PG8_SB(0, 1), b2 + hstepB, voffB); PG8_STAGE(PG8_SA(0, 0), a2, voffA);
            PG8_WAIT_V(8); PG8_WAIT_L(0); PG8_BAR; PG8_MMA(1, 0, At, B0); PG8_MMA(1, 1, At, B1); PG8_BAR; PG8_SCHED;
            PG8_LDB(B0, 1, 0); PG8_LDB(B1, 1, 1); PG8_SCHED; PG8_LDA(At, 1, 0); PG8_STAGE(PG8_SA(0, 1), a2 + hstepA, voffA);
            PG8_WAIT_V(8); PG8_WAIT_L(0); PG8_BAR; PG8_MMA(0, 0, At, B0); PG8_MMA(0, 1, At, B1); PG8_BAR; PG8_SCHED;
            PG8_LDA(At, 1, 1); PG8_STAGE(PG8_SB(1, 0), b3, voffB); PG8_STAGE(PG8_SB(1, 1), b3 + hstepB, voffB); PG8_STAGE(PG8_SA(1, 0), a3, voffA);
            PG8_WAIT_V(8); PG8_WAIT_L(0); PG8_BAR; PG8_MMA(1, 0, At, B0); PG8_MMA(1, 1, At, B1); PG8_BAR; PG8_SCHED;
        }
        if (wr == 0) PG8_BAR;
        E(acc, cur, wr, wc, fr, fq);
        if (!has_next) break;
#pragma unroll
        for (int a = 0; a < 2; ++a)
#pragma unroll
            for (int b = 0; b < 2; ++b)
#pragma unroll
                for (int m = 0; m < 4; ++m)
#pragma unroll
                    for (int n = 0; n < 2; ++n) acc[a][b][m][n] = (f32x4){0.f, 0.f, 0.f, 0.f};
        cur = nxt; cA = nA; cB = nB; ++ui;
        if (wr == 1) PG8_BAR;
    }
    PG8_WAIT_V(0);
    PG8_BAR;
#undef PG8_SA
#undef PG8_SB
#undef PG8_STAGE
#undef PG8_LDA
#undef PG8_LDB
#undef PG8_MMA
#undef PG8_WAIT_V
#undef PG8_WAIT_L
#undef PG8_BAR
#undef PG8_SCHED
}

typedef f32x4 AccT[2][2][4][2];
struct RsTab { const LAS float* tab; int p0, p1, p2, p3; const float* ss;
    __device__ __forceinline__ float get(int pm, int rloc, int row) const {
        const int slot = pm == p0 ? 0 : (pm == p1 ? 1 : (pm == p2 ? 2 : (pm == p3 ? 3 : -1)));
        return slot >= 0 ? tab[slot * 256 + rloc] : rs16(ss, row); }
};
__device__ __forceinline__ void build_rstab(RsTab& T, LAS unsigned char* lds, const float* ss, const StaticOrder& S) {
    int p0 = -1, p1 = -1, p2 = -1, p3 = -1;
    for (int i = 0;; ++i) { Unit u; if (!S.next(i, u)) break; const int pm = u.pm;
        if (pm == p0 || pm == p1 || pm == p2 || pm == p3) continue;
        if (p0 < 0) p0 = pm; else if (p1 < 0) p1 = pm; else if (p2 < 0) p2 = pm; else if (p3 < 0) p3 = pm; }
    LAS float* tab = (LAS float*)(lds + STAGE_BYTES);
    const int tid = threadIdx.x, rl = tid & 255, sl = tid >> 8;
    { const int pa = sl == 0 ? p0 : p1; if (pa >= 0) tab[sl * 256 + rl] = rs16(ss, rowstart(pa) + rl); }
    { const int pb = sl == 0 ? p2 : p3; if (pb >= 0) tab[(2 + sl) * 256 + rl] = rs16(ss, rowstart(pb) + rl); }
    __syncthreads();
    T.tab = tab; T.p0 = p0; T.p1 = p1; T.p2 = p2; T.p3 = p3; T.ss = ss;
}
struct EpiSwiGLU { static constexpr bool PERM = true, USE_RS = true; bf16_t* O; int ldo; const float* ss; RsTab T;
    __device__ __forceinline__ void operator()(const AccT& acc, const Unit& u, int wr, int wc, int fr, int fq) const {
        const int row0 = rowstart(u.pm) + wr * 64 + fr, j0 = u.pn * 128 + wc * 32 + 8 * fq;
#pragma unroll
        for (int ai = 0; ai < 2; ++ai)
#pragma unroll
            for (int m = 0; m < 4; ++m) { const int row = row0 + ai * HALF + m * 16; float v[8]; const float rs = T.get(u.pm, wr * 64 + fr + ai * HALF + m * 16, row);
#pragma unroll
                for (int n = 0; n < 2; ++n)
#pragma unroll
                    for (int e = 0; e < 4; ++e) { const float gt = acc[ai][0][m][n][e] * rs, up = acc[ai][1][m][n][e] * rs; v[4 * n + e] = gt * sigmoidf_(gt) * up; }
                u32x4 w; w.x = pk2(v[0], v[1]); w.y = pk2(v[2], v[3]); w.z = pk2(v[4], v[5]); w.w = pk2(v[6], v[7]);
                *(u32x4*)(O + (size_t)row * ldo + j0) = w; }
    }
};
struct EpiGLU { static constexpr bool PERM = true, USE_RS = true; bf16_t* O; const float* bias; const float* ss; RsTab T;
    __device__ __forceinline__ void operator()(const AccT& acc, const Unit& u, int wr, int wc, int fr, int fq) const {
        const int row0 = rowstart(u.pm) + wr * 64 + fr, j0 = u.pn * 128 + wc * 32 + 8 * fq;
        float ba[8], bg[8];
#pragma unroll
        for (int e = 0; e < 8; ++e) { ba[e] = bias[j0 + e]; bg[e] = bias[DM + j0 + e]; }
#pragma unroll
        for (int ai = 0; ai < 2; ++ai)
#pragma unroll
            for (int m = 0; m < 4; ++m) { const int row = row0 + ai * HALF + m * 16; float v[8]; const float rs = T.get(u.pm, wr * 64 + fr + ai * HALF + m * 16, row);
#pragma unroll
                for (int n = 0; n < 2; ++n)
#pragma unroll
                    for (int e = 0; e < 4; ++e) { const float a = acc[ai][0][m][n][e] * rs + ba[4 * n + e], gt = acc[ai][1][m][n][e] * rs + bg[4 * n + e]; v[4 * n + e] = a * sigmoidf_(gt); }
                u32x4 w; w.x = pk2(v[0], v[1]); w.y = pk2(v[2], v[3]); w.z = pk2(v[4], v[5]); w.w = pk2(v[6], v[7]);
                *(u32x4*)(O + (size_t)row * DM + j0) = w; }
    }
};
constexpr int KV_TILES = 258; constexpr size_t KV_BH_BYTES = (size_t)KV_TILES * 16384;
struct EpiQKV { static constexpr bool PERM = true, USE_RS = true; bf16_t* Q; unsigned char* Kimg; unsigned char* Vimg; const float* ss; RsTab T;
    __device__ __forceinline__ void operator()(const AccT& acc, const Unit& u, int wr, int wc, int fr, int fq) const {
        const int row0 = rowstart(u.pm) + wr * 64 + fr, c00 = u.pn * BM + wc * 32 + 8 * fq;
        const int region = (u.pn * BM) >> 10, b = u.pm >> 6;
        const float sc = region == 0 ? QSCALE : 1.0f;
#pragma unroll
        for (int ai = 0; ai < 2; ++ai)
#pragma unroll
            for (int m = 0; m < 4; ++m) { const int row = row0 + ai * HALF + m * 16; const float rs = sc * T.get(u.pm, wr * 64 + fr + ai * HALF + m * 16, row);
                const int pos = row - b * LSEQ - NMETA, tile = 1 + (pos >> 6), rin = pos & 63;
#pragma unroll
                for (int bj = 0; bj < 2; ++bj) { const f32x4 v0 = acc[ai][bj][m][0] * rs, v1 = acc[ai][bj][m][1] * rs;
                    u32x4 w; w.x = pk2(v0[0], v0[1]); w.y = pk2(v0[2], v0[3]); w.z = pk2(v1[0], v1[1]); w.w = pk2(v1[2], v1[3]);
                    const int c = c00 + bj * HALF;
                    if (region == 0) *(u32x4*)(Q + (size_t)row * DM + c) = w;
                    else { const int cc = c & 1023, h = cc >> 7, d = cc & 127; const size_t tb = (size_t)(b * 8 + h) * KV_BH_BYTES + (size_t)tile * 16384;
                        if (region == 1) *(u32x4*)(Kimg + tb + (d >> 3) * 1024 + rin * 16) = w;
                        else *(u32x4*)(Vimg + tb + (d >> 5) * 4096 + rin * 64 + (d & 31) * 2) = w; } } }
    }
};
struct EpiResid { static constexpr bool PERM = true, USE_RS = false; float* H; const float* bias; const float* scale; bf16_t* HB; float* ss_out;
    __device__ __forceinline__ void operator()(const AccT& acc, const Unit& u, int wr, int wc, int fr, int fq) const {
        const int row0 = rowstart(u.pm) + wr * 64 + fr, col0 = u.pn * BM + wc * 32 + 8 * fq;
        f32x4 bv[2][2], sv[2][2];
#pragma unroll
        for (int bj = 0; bj < 2; ++bj)
#pragma unroll
            for (int n = 0; n < 2; ++n) { bv[bj][n] = bias ? *(const f32x4*)(bias + col0 + bj * HALF + n * 4) : (f32x4){0.f, 0.f, 0.f, 0.f};
                                          sv[bj][n] = scale ? *(const f32x4*)(scale + col0 + bj * HALF + n * 4) : (f32x4){1.f, 1.f, 1.f, 1.f}; }
#pragma unroll
        for (int ai = 0; ai < 2; ++ai)
#pragma unroll
            for (int m = 0; m < 4; ++m) { const int row = row0 + ai * HALF + m * 16;
                { bf16_t* hbp = HB + (size_t)row * DM + col0; float sq = 0.f;
#pragma unroll
                    for (int bj = 0; bj < 2; ++bj) { u32x4* p = (u32x4*)(hbp + bj * HALF); const u32x4 ho = *p;
                        const f32x4 h0 = {bflo(ho.x), bfhi(ho.x), bflo(ho.y), bfhi(ho.y)}, h1 = {bflo(ho.z), bfhi(ho.z), bflo(ho.w), bfhi(ho.w)};
                        const f32x4 a0 = h0 + (acc[ai][bj][m][0] + bv[bj][0]) * sv[bj][0], a1 = h1 + (acc[ai][bj][m][1] + bv[bj][1]) * sv[bj][1];
                        u32x4 w; w.x = pk2(a0[0], a0[1]); w.y = pk2(a0[2], a0[3]); w.z = pk2(a1[0], a1[1]); w.w = pk2(a1[2], a1[3]); *p = w;
                        sq += ((a0[0] * a0[0] + a0[1] * a0[1]) + (a0[2] * a0[2] + a0[3] * a0[3])) + ((a1[0] * a1[0] + a1[1] * a1[1]) + (a1[2] * a1[2] + a1[3] * a1[3])); }
                    sq += __shfl_xor(sq, 16); sq += __shfl_xor(sq, 32);
                    if (fq == 0) ss_out[(size_t)row * 16 + u.pn * 4 + wc] = sq; } }
    }
};
template <class Epi> __device__ __forceinline__ void run_gemm(LAS unsigned char* lds, const bf16_t* A, int lda, const bf16_t* Bt, int N, int K, int grouped, Epi& E) {
    Gemm g; g.A = A; g.Bt = Bt; g.M = BATCH * SEQ; g.N = N; g.K = K; g.lda = lda; g.grouped = grouped;
    StaticOrder S; S.init(BATCH * SEQ, N, (int)gridDim.x, (int)blockIdx.x);
    if constexpr (Epi::USE_RS) build_rstab(E.T, lds, E.ss, S);
    gemm_phase<Epi>(lds, g, S, E);
}

struct MEpiSwiGLU { static constexpr bool PAIR = true; bf16_t* O; const float* ss;
    __device__ __forceinline__ float pre(int lane) const { return rs64(ss, lane & 15); }
    __device__ __forceinline__ void operator()(const f32x4& g_, const f32x4& u_, int task, int lane, float rs) const {
        const f32x4 g = g_ * rs, u = u_ * rs;
        const int r = lane & 15, j = (task >> 3) * 128 + (task & 7) * 16 + 4 * (lane >> 4);
        u32x2 w; w.x = pk2(g[0] * sigmoidf_(g[0]) * u[0], g[1] * sigmoidf_(g[1]) * u[1]); w.y = pk2(g[2] * sigmoidf_(g[2]) * u[2], g[3] * sigmoidf_(g[3]) * u[3]);
        *(u32x2*)(O + (size_t)r * FF + j) = w; *(u32x2*)(O + (size_t)(LSEQ + r) * FF + j) = w; }
};
struct MEpiGLU { static constexpr bool PAIR = true; bf16_t* O; const float* bias; const float* ss;
    __device__ __forceinline__ float pre(int lane) const { return rs64(ss, lane & 15); }
    __device__ __forceinline__ void operator()(const f32x4& av, const f32x4& gv, int task, int lane, float rs) const {
        const int r = lane & 15, j = (task >> 3) * 128 + (task & 7) * 16 + 4 * (lane >> 4); float v[4];
#pragma unroll
        for (int e = 0; e < 4; ++e) v[e] = (av[e] * rs + bias[j + e]) * sigmoidf_(gv[e] * rs + bias[DM + j + e]);
        u32x2 w; w.x = pk2(v[0], v[1]); w.y = pk2(v[2], v[3]);
        *(u32x2*)(O + (size_t)r * DM + j) = w; *(u32x2*)(O + (size_t)(LSEQ + r) * DM + j) = w; }
};
struct MEpiQKV { static constexpr bool PAIR = false; bf16_t* Q; unsigned char* Kimg; unsigned char* Vimg; const float* ss;
    __device__ __forceinline__ float pre(int lane) const { return rs64(ss, lane & 15); }
    __device__ __forceinline__ void operator()(const f32x4& v, const f32x4&, int task, int lane, float rs) const {
        const int r = lane & 15, c = task * 16 + 4 * (lane >> 4); const float sc = (c < DM ? QSCALE : 1.0f) * rs;
        u32x2 w; w.x = pk2(v[0] * sc, v[1] * sc); w.y = pk2(v[2] * sc, v[3] * sc);
        const int region = c >> 10, cc = c & 1023, h = cc >> 7, d = cc & 127;
#pragma unroll
        for (int b = 0; b < 2; ++b) {
            if (region == 0) *(u32x2*)(Q + (size_t)(b * LSEQ + r) * DM + c) = w;
            else { const size_t tb = (size_t)(b * 8 + h) * KV_BH_BYTES;
                if (region == 1) *(u32x2*)(Kimg + tb + (d >> 3) * 1024 + r * 16 + (d & 7) * 2) = w;
                else *(u32x2*)(Vimg + tb + (d >> 5) * 4096 + r * 64 + (d & 31) * 2) = w; } } }
};
struct MEpiResid { static constexpr bool PAIR = false; float* H; const float* bias; const float* scale; bf16_t* HB; float* ss_out;
    __device__ __forceinline__ float pre(int) const { return 1.0f; }
    __device__ __forceinline__ void operator()(const f32x4& v, const f32x4&, int task, int lane, float) const {
        const int r = lane & 15, c = task * 16 + 4 * (lane >> 4);
        const f32x4 bv = bias ? *(const f32x4*)(bias + c) : (f32x4){0.f, 0.f, 0.f, 0.f}, sv = scale ? *(const f32x4*)(scale + c) : (f32x4){1.f, 1.f, 1.f, 1.f};
        const f32x4 d = (v + bv) * sv;
        const u32x2 ho = *(const u32x2*)(HB + (size_t)r * DM + c); const f32x4 h0 = {bflo(ho.x), bfhi(ho.x), bflo(ho.y), bfhi(ho.y)};
        const f32x4 hn = h0 + d;
        u32x2 w; w.x = pk2(hn[0], hn[1]); w.y = pk2(hn[2], hn[3]); *(u32x2*)(HB + (size_t)r * DM + c) = w; *(u32x2*)(HB + (size_t)(LSEQ + r) * DM + c) = w;
        float sq = (hn[0] * hn[0] + hn[1] * hn[1]) + (hn[2] * hn[2] + hn[3] * hn[3]); sq += __shfl_xor(sq, 16); sq += __shfl_xor(sq, 32);
        if ((lane >> 4) == 0) ss_out[r * 64 + task] = sq; }
};
template <int K, class MEpi> __device__ __forceinline__ void meta_gemm(LAS unsigned char* lds, const bf16_t* A, int lda, const bf16_t* Bt, int ntasks, int grouped, const MEpi& E) {
    const int tid = threadIdx.x, lane = tid & 63, wid = __builtin_amdgcn_readfirstlane(tid >> 6), G = (int)gridDim.x;
    constexpr int kw = K / 8;
    LAS f32x4* part = (LAS f32x4*)lds;
    for (int task = (int)blockIdx.x; task < ntasks; task += G) {
        const int nb0 = MEpi::PAIR ? (task >> 3) * 256 + (task & 7) * 16 : task * 16;
        const int acol = grouped ? (task >> 4) * 256 : 0;
        const bf16_t* ap = A + (size_t)(lane & 15) * lda + acol + wid * kw + 8 * (lane >> 4);
        const bf16_t* bp = Bt + (size_t)(nb0 + (lane & 15)) * K + wid * kw + 8 * (lane >> 4);
        f32x4 acc0 = {0.f, 0.f, 0.f, 0.f}, acc1 = {0.f, 0.f, 0.f, 0.f};
        float rsv = 1.0f; if (wid == 0) rsv = E.pre(lane);
        constexpr int NS = kw / 32;
        bf16x8 af[NS], b0[NS], b1[MEpi::PAIR ? NS : 1];
#pragma unroll
        for (int i = 0; i < NS; ++i) { af[i] = *(const bf16x8*)(ap + 32 * i); b0[i] = *(const bf16x8*)(bp + 32 * i); if (MEpi::PAIR) b1[i] = *(const bf16x8*)(bp + (size_t)128 * K + 32 * i); }
#pragma unroll
        for (int i = 0; i < NS; ++i) { acc0 = __builtin_amdgcn_mfma_f32_16x16x32_bf16(b0[i], af[i], acc0, 0, 0, 0);
            if (MEpi::PAIR) acc1 = __builtin_amdgcn_mfma_f32_16x16x32_bf16(b1[i], af[i], acc1, 0, 0, 0); }
        part[wid * 64 + lane] = acc0; if (MEpi::PAIR) part[512 + wid * 64 + lane] = acc1;
        __syncthreads();
        if (wid == 0) { f32x4 s0 = part[lane], s1 = {0.f, 0.f, 0.f, 0.f};
#pragma unroll
            for (int w = 1; w < 8; ++w) s0 = s0 + part[w * 64 + lane];
            if (MEpi::PAIR) { s1 = part[512 + lane];
#pragma unroll
                for (int w = 1; w < 8; ++w) s1 = s1 + part[512 + w * 64 + lane]; }
            E(s0, s1, task, lane, rsv); }
        __syncthreads();
    }
}
}

__device__ __forceinline__ void transpose_item(const float* W, int K, int N, bf16_t* WT, int k0, int n0, int out_row0, LAS float* scr, int lane, const float* gk = nullptr) {
    float wv_[32];
#pragma unroll
    for (int i = 0; i < 32; ++i) { const int kk = 2 * i + (lane >> 5); wv_[i] = W[(size_t)(k0 + kk) * N + n0 + (lane & 31)]; }
    if (gk) {
#pragma unroll
        for (int i = 0; i < 32; ++i) wv_[i] *= gk[k0 + 2 * i + (lane >> 5)]; }
#pragma unroll
    for (int i = 0; i < 32; ++i) { const int kk = 2 * i + (lane >> 5); scr[kk * 33 + (lane & 31)] = wv_[i]; }
    asm volatile("s_waitcnt lgkmcnt(0)" ::: "memory");
    const int c = lane & 7;
#pragma unroll
    for (int j = 0; j < 4; ++j) { const int n = (lane >> 3) + 8 * j; const LAS float* s = scr + (8 * c) * 33 + n;
        u32x4 o; o.x = pk2(s[0 * 33], s[1 * 33]); o.y = pk2(s[2 * 33], s[3 * 33]); o.z = pk2(s[4 * 33], s[5 * 33]); o.w = pk2(s[6 * 33], s[7 * 33]);
        *(u32x4*)(WT + (size_t)(out_row0 + n) * K + k0 + 8 * c) = o; }
    asm volatile("s_waitcnt lgkmcnt(0)" ::: "memory");
}
__device__ __forceinline__ void transpose_matrix(const float* W, int K, int N, bf16_t* WT, int mode, LAS float* scr, int gw, int ngw, int lane, const float* gk = nullptr) {
    const int nblk = N / 32, items = (K / 64) * nblk;
    for (int it = gw; it < items; it += ngw) { const int kb = it / nblk, nb = it % nblk, n0 = 32 * nb;
        const int orow = mode == 0 ? n0 : ((n0 / 128) * 256 + (n0 % 128) + (mode == 2 ? 128 : 0));
        transpose_item(W, K, N, WT, 64 * kb, n0, orow, scr, lane, gk); }
}

__device__ __forceinline__ void init_row(const float* src, float* hrow, bf16_t* hb, float* ssp, float* ssm, int lane) {
    float s = 0.f;
#pragma unroll
    for (int j = 0; j < 4; ++j) { const f32x4 v = *((const f32x4*)src + lane + 64 * j); s += (v.x * v.x + v.y * v.y) + (v.z * v.z + v.w * v.w);
        u32x2 o; o.x = pk2(v.x, v.y); o.y = pk2(v.z, v.w); *((u32x2*)hb + lane + 64 * j) = o; }
    s = wave_sum(s); if (lane < 16) ssp[lane] = lane == 0 ? s : 0.f;
    if (ssm) ssm[lane] = lane == 0 ? s : 0.f;
}
__device__ __forceinline__ void norm_row(const float* src, const float* g, bf16_t* yrow, float* hcopy, float* fout, int lane) {
    f32x4 v[4]; float s = 0.f;
#pragma unroll
    for (int j = 0; j < 4; ++j) { v[j] = *((const f32x4*)src + lane + 64 * j); s += (v[j].x * v[j].x + v[j].y * v[j].y) + (v[j].z * v[j].z + v[j].w * v[j].w); }
    const float rs = 1.0f / sqrtf(wave_sum(s) * (1.0f / DM) + 1e-6f);
#pragma unroll
    for (int j = 0; j < 4; ++j) {
        if (hcopy) *((f32x4*)hcopy + lane + 64 * j) = v[j];
        const f32x4 gv = *((const f32x4*)g + lane + 64 * j); const f32x4 y = v[j] * rs * gv;
        if (fout) *((f32x4*)fout + lane + 64 * j) = y;
        if (yrow) { u32x2 o; o.x = pk2(y.x, y.y); o.y = pk2(y.z, y.w); *((u32x2*)yrow + lane + 64 * j) = o; }
    }
}

namespace att {
constexpr int A_K = 0, A_V = 65536, A_LUT = 131072, A_SCR = 131072 + 1024, A_X = 0;
__device__ __forceinline__ int crow(int r, int hi) { return (r & 3) + 8 * (r >> 2) + 4 * hi; }
__device__ __forceinline__ s16x4 vtr(const LAS unsigned char* p) { typedef short v4i16_t __attribute__((ext_vector_type(4))); return __builtin_bit_cast(s16x4, __builtin_amdgcn_ds_read_tr16_b64_v4i16((LAS v4i16_t*)p)); }
#define ATT_SB() do {} while (0)
__device__ __forceinline__ void glds16(const void* gsrc, unsigned lds_dst) { unsigned keep;
    asm volatile("s_mov_b32 %0, m0\n\ts_mov_b32 m0, %2\n\ts_nop 0\n\tglobal_load_lds_dwordx4 %1, off\n\ts_mov_b32 m0, %0" : "=&s"(keep) : "v"(gsrc), "s"(lds_dst) : "memory"); }
#define ATT_WAITBAR(N) asm volatile("s_waitcnt vmcnt(" #N ") lgkmcnt(0)\n\ts_barrier" ::: "memory")
#define ATT_MIDBAR() asm volatile("s_waitcnt lgkmcnt(0)\n\ts_barrier" ::: "memory")
__device__ __forceinline__ float xhalf_max(float v) { auto rr = __builtin_amdgcn_permlane32_swap(__float_as_uint(v), __float_as_uint(v), false, false); return fmaxf(__uint_as_float(rr[0]), __uint_as_float(rr[1])); }
__device__ __forceinline__ float xhalf_sum(float v) { auto rr = __builtin_amdgcn_permlane32_swap(__float_as_uint(v), __float_as_uint(v), false, false); return __uint_as_float(rr[0]) + __uint_as_float(rr[1]); }
template <int XM> __device__ __forceinline__ float swz_xor(float v) { return __int_as_float(__builtin_amdgcn_ds_swizzle(__float_as_int(v), (XM << 10) | 0x1F)); }

__device__ __forceinline__ float max3a(float a, float b, float c) { float r; asm("v_max3_f32 %0, %1, %2, %3" : "=v"(r) : "v"(a), "v"(b), "v"(c)); return r; }
__device__ __forceinline__ void att_qs(bf16x8 (&pn)[4], f32x16 (&o)[4], f32x16& osum, f32x16& negm, const bf16x8 (&qf)[4], float& m_hat,
                                       const LAS unsigned char* kb, LAS float* scr, const LAS float* lut, int hi, int i32, bool near, int lutbase, bool first_tile) {
    __builtin_amdgcn_s_setprio(1);
    f32x16 c0, c1;
    bf16x8 kf[4];
#define ATT_KREAD(i) (*(const LAS bf16x8*)(kb + ((i) >> 1) * 2048 + ((i) & 1) * 512))
    kf[0] = ATT_KREAD(0); kf[1] = ATT_KREAD(1); kf[2] = ATT_KREAD(2); kf[3] = ATT_KREAD(3);
    __builtin_amdgcn_sched_barrier(0);
#pragma unroll
    for (int i = 0; i < 8; ++i) {
        if (i == 0) c0 = __builtin_amdgcn_mfma_f32_32x32x16_bf16(kf[0], qf[0], negm, 0, 0, 0);
        else if (i == 1) c1 = __builtin_amdgcn_mfma_f32_32x32x16_bf16(kf[1], qf[0], negm, 0, 0, 0);
        else if ((i & 1) == 0) c0 = __builtin_amdgcn_mfma_f32_32x32x16_bf16(kf[i & 3], qf[i >> 1], c0, 0, 0, 0);
        else c1 = __builtin_amdgcn_mfma_f32_32x32x16_bf16(kf[i & 3], qf[i >> 1], c1, 0, 0, 0);
        if (i + 4 < 8) kf[i & 3] = ATT_KREAD(i + 4);
        __builtin_amdgcn_sched_barrier(0);
    }
#undef ATT_KREAD
    if (near) {
#pragma unroll
        for (int r = 0; r < 16; ++r) { int i0 = lutbase + crow(r, hi), i1 = i0 + 32; i0 = i0 < 0 ? 0 : (i0 > 255 ? 255 : i0); i1 = i1 < 0 ? 0 : (i1 > 255 ? 255 : i1); c0[r] += lut[i0]; c1[r] += lut[i1]; }
    }
    if (first_tile) {
#pragma unroll
        for (int r = 0; r < 16; ++r) { if (crow(r, hi) >= NMETA) c0[r] = -INFINITY; c1[r] = -INFINITY; }
    }
    asm volatile("s_nop 15\n\ts_nop 7" : "+v"(c0), "+v"(c1));
    float rm;
    { float a = max3a(c0[0], c0[1], c0[2]), b = max3a(c1[0], c1[1], c1[2]);
#pragma unroll
      for (int r = 3; r < 15; r += 2) { a = max3a(a, c0[r], c0[r + 1]); b = max3a(b, c1[r], c1[r + 1]); }
      rm = max3a(a, b, c0[15]); rm = max3a(rm, c1[15], c1[15]); }
    rm = xhalf_max(rm);
    if (first_tile) {
        m_hat += rm;
#pragma unroll
        for (int r = 0; r < 16; ++r) { c0[r] -= rm; c1[r] -= rm; negm[r] = -m_hat; }
    } else if (__any(rm > 8.0f)) {
        const float dl = fmaxf(rm, 0.f); m_hat += dl; const float f = __builtin_amdgcn_exp2f(-dl);
#pragma unroll
        for (int r = 0; r < 16; ++r) { c0[r] -= dl; c1[r] -= dl; negm[r] = -m_hat; }
        if (hi == 0) scr[i32] = f;
        asm volatile("s_waitcnt lgkmcnt(0)" ::: "memory");
#pragma unroll
        for (int r = 0; r < 16; ++r) { const float fr_ = scr[crow(r, hi)]; osum[r] *= fr_;
#pragma unroll
            for (int d = 0; d < 4; ++d) o[d][r] *= fr_; }
    }
    unsigned paw[16];
#pragma unroll
    for (int g = 0; g < 8; ++g) { const int b = (4 * g) & 15;
        const float v0 = __builtin_amdgcn_exp2f(g < 4 ? c0[b] : c1[b]), v1 = __builtin_amdgcn_exp2f(g < 4 ? c0[b + 1] : c1[b + 1]);
        const float v2 = __builtin_amdgcn_exp2f(g < 4 ? c0[b + 2] : c1[b + 2]), v3 = __builtin_amdgcn_exp2f(g < 4 ? c0[b + 3] : c1[b + 3]);
        paw[2 * g] = pk2(v0, v1); paw[2 * g + 1] = pk2(v2, v3); }
#pragma unroll
    for (int k = 0; k < 4; ++k) { u32x4 w; w.x = paw[4 * k]; w.y = paw[4 * k + 1]; w.z = paw[4 * k + 2]; w.w = paw[4 * k + 3]; pn[k] = __builtin_bit_cast(bf16x8, w); }
    __builtin_amdgcn_s_setprio(0);
}
__device__ __forceinline__ void att_pv(const bf16x8 (&pp)[4], f32x16 (&o)[4], f32x16& osum, const LAS unsigned char* vb) {
    s16x4 vl[2][4], vh[2][4];
#define ATT_VREADK(ks) do { _Pragma("unroll") for (int d_ = 0; d_ < 4; ++d_) { vl[(ks) & 1][d_] = vtr(vb + d_ * 4096 + (ks) * 1024); vh[(ks) & 1][d_] = vtr(vb + d_ * 4096 + (ks) * 1024 + 512); } } while (0)
    const bf16x8 ones = (bf16x8){0x3F80, 0x3F80, 0x3F80, 0x3F80, 0x3F80, 0x3F80, 0x3F80, 0x3F80};
    ATT_VREADK(0);
#pragma unroll
    for (int ks = 0; ks < 4; ++ks) {
        if (ks + 1 < 4) ATT_VREADK(ks + 1);
        osum = __builtin_amdgcn_mfma_f32_32x32x16_bf16(pp[ks], ones, osum, 0, 0, 0);
#pragma unroll
        for (int d = 0; d < 4; ++d) { const int bk = ks & 1;
            const bf16x8 vf = (bf16x8){vl[bk][d][0], vl[bk][d][1], vl[bk][d][2], vl[bk][d][3], vh[bk][d][0], vh[bk][d][1], vh[bk][d][2], vh[bk][d][3]};
            o[d] = __builtin_amdgcn_mfma_f32_32x32x16_bf16(pp[ks], vf, o[d], 0, 0, 0); }
    }
#undef ATT_VREADK
}

__device__ __forceinline__ void attn_unit(LAS unsigned char* lds, const bf16_t* Qb, const unsigned char* Kimg, const unsigned char* Vimg, bf16_t* AO, int b, int h, int qpos0, int ntiles, int store_limit,
                                          const float* relb, const float* subg, float lam, float post) {
    const int tid = threadIdx.x, lane = tid & 63, i32 = lane & 31, hi = lane >> 5; const int wid = __builtin_amdgcn_readfirstlane(tid >> 6);
    const int c = wid >> 2, qg = wid & 3;
    const size_t rowbase = (size_t)b * LSEQ;
    LAS float* lut = (LAS float*)(lds + A_LUT);
    LAS float* scr = (LAS float*)(lds + A_SCR) + wid * 32;
    if (tid < 256) { const int rel = tid - 128; const int n = rel < 0 ? -rel : rel; int bk;
        if (n < 8) bk = n; else { const float lr = logf((float)n / 8.0f) / 2.772588722239781f; int lg = 8 + (int)(lr * 8.0f); bk = lg < 15 ? lg : 15; }
        if (rel > 0) bk += 16;
        lut[tid] = (relb[bk * 8 + h] - relb[15 * 8 + h]) * LOG2E; }
    const int qp_w = qpos0 + 32 * qg;
    const int qpos = qp_w + i32;
    bf16x8 qf[4];
    { const int qr = qpos < LSEQ ? qpos : LSEQ - 1; const bf16_t* qp = Qb + (rowbase + qr) * DM + h * 128 + c * 64 + 8 * hi;
#pragma unroll
      for (int d0 = 0; d0 < 4; ++d0) qf[d0] = *(const bf16x8*)(qp + 16 * d0); }
    const int ch_w = qp_w < NMETA ? 0 : 1 + (qp_w - NMETA) / 64;
    const int T_w = ch_w < ntiles - 1 ? ch_w : ntiles - 1;
    const unsigned char* kg0 = Kimg + (size_t)(b * 8 + h) * pg8::KV_BH_BYTES + wid * 1024 + lane * 16;
    const unsigned char* vg0 = Vimg + (size_t)(b * 8 + h) * pg8::KV_BH_BYTES + wid * 1024 + lane * 16;
#define TILE_POS(tt) ((tt) == 0 ? 0 : NMETA + 64 * ((tt) - 1))
    const unsigned lds0 = (unsigned)(uintptr_t)lds;
#define DMA_TILE(tt) do { const int t_ = (tt) < ntiles ? (tt) : ntiles - 1; const size_t kp_ = (size_t)t_ * 16384; const unsigned sl_ = (unsigned)(((tt) & 3) * 16384) + (unsigned)wid * 1024u; \
        const unsigned kd_ = (unsigned)__builtin_amdgcn_readfirstlane(lds0 + A_K + sl_), vd_ = (unsigned)__builtin_amdgcn_readfirstlane(lds0 + A_V + sl_); \
        glds16(kg0 + kp_, kd_); glds16(kg0 + kp_ + 8192, kd_ + 8192u); glds16(vg0 + kp_, vd_); glds16(vg0 + kp_ + 8192, vd_ + 8192u); } while (0)
    f32x16 o[4];
#pragma unroll
    for (int d = 0; d < 4; ++d)
#pragma unroll
        for (int r = 0; r < 16; ++r) o[d][r] = 0.f;
    bf16x8 pn[4];
#pragma unroll
    for (int k = 0; k < 4; ++k) pn[k] = (bf16x8){0, 0, 0, 0, 0, 0, 0, 0};
    f32x16 osum, negm;
#pragma unroll
    for (int r = 0; r < 16; ++r) { osum[r] = 0.f; negm[r] = 0.f; }
    float m_hat = 0.f;
    DMA_TILE(0); DMA_TILE(1);
    ATT_WAITBAR(4);
    const LAS unsigned char* kfb = lds + A_K + (8 * c + hi) * 1024 + i32 * 16;
    const LAS unsigned char* vfb = lds + A_V + ((lane >> 4) & 1) * 32 + (lane & 3) * 8 + (4 * hi + ((lane & 15) >> 2)) * 64;
#define ATT_COMMON(tt) \
        const int kp0_ = TILE_POS(tt); const bool near_ = (kp0_ + 63 - qp_w) >= -90; const int lb_ = kp0_ - qpos + 128; const LAS unsigned char* kb_ = kfb + ((tt) & 3) * 16384;
    if (c == 0) {
        for (int tt = 0; tt < ntiles; ++tt) {
            ATT_COMMON(tt)
            if (tt <= T_w) att_qs(pn, o, osum, negm, qf, m_hat, kb_, scr, lut, hi, i32, near_, lb_, tt == 0);
            DMA_TILE(tt + 2);
            if (tt <= T_w) att_pv(pn, o, osum, vfb + (tt & 3) * 16384);
            ATT_WAITBAR(4);
        }
    } else {
        for (int tt = 0; tt < ntiles; ++tt) {
            ATT_COMMON(tt)
            if (tt >= 1 && tt - 1 <= T_w) att_pv(pn, o, osum, vfb + ((tt - 1) & 3) * 16384);
            if (tt <= T_w) att_qs(pn, o, osum, negm, qf, m_hat, kb_, scr, lut, hi, i32, near_, lb_, tt == 0);
            DMA_TILE(tt + 2);
            ATT_WAITBAR(4);
        }
        if (ntiles - 1 <= T_w) att_pv(pn, o, osum, vfb + ((ntiles - 1) & 3) * 16384);
    }
    asm volatile("s_waitcnt vmcnt(0)" ::: "memory");
#undef ATT_COMMON
    __syncthreads();
    { const float num = (c == 0 ? 1.0f : -lam);
#pragma unroll
      for (int r = 0; r < 16; ++r) { const float fr_ = num / osum[r];
#pragma unroll
          for (int d = 0; d < 4; ++d) o[d][r] *= fr_; } }
    LAS float* X = (LAS float*)(lds + A_X) + qg * (32 * 128);
    if (c == 1) {
#pragma unroll
        for (int r = 0; r < 16; ++r)
#pragma unroll
            for (int d = 0; d < 4; ++d) X[crow(r, hi) * 128 + 32 * d + i32] = o[d][r];
    }
    __syncthreads();
    if (c == 0) {
        float sg[4];
#pragma unroll
        for (int d = 0; d < 4; ++d) sg[d] = subg[32 * d + i32] * post;
#pragma unroll
        for (int r = 0; r < 16; ++r) { const int qr = crow(r, hi); float ss = 0.f;
#pragma unroll
            for (int d = 0; d < 4; ++d) { o[d][r] += X[qr * 128 + 32 * d + i32]; ss += o[d][r] * o[d][r]; }
            ss += swz_xor<1>(ss); ss += swz_xor<2>(ss); ss += swz_xor<4>(ss); ss += swz_xor<8>(ss); ss += swz_xor<16>(ss);
            const float rs = 1.0f / sqrtf(ss * (1.0f / 128.0f) + 1e-5f);
            const int qp = qp_w + qr;
            if (qp < store_limit) { bf16_t* op = AO + (rowbase + qp) * DM + h * 128 + i32;
#pragma unroll
                for (int d = 0; d < 4; ++d) op[32 * d] = (bf16_t)f2bf(o[d][r] * rs * sg[d]); } }
    }
    __syncthreads();
#undef TILE_POS
#undef DMA_TILE
}
#undef ATT_SB
}

struct Args {
    const float* x; const float* meta; const float* norm_mix_g; const float* norm_ffn_g; const float* final_g; const float* relb;
    const float* pool_w; const float* pool_b; const float* pool_scale;
    const float* w_qkv; const float* w_o; const float* lq1; const float* lk1; const float* lq2; const float* lk2; const float* subg;
    const float* c_win; const float* c_bin; const float* c_dww; const float* c_dwb; const float* c_lng; const float* c_lnb; const float* c_wout; const float* c_bout;
    const float* f_wg; const float* f_wu; const float* f_wd;
    float* out; unsigned char* ws; int ph_lo, ph_hi;
};


__device__ __forceinline__ void ffn_up(LAS unsigned char* lds, const bf16_t* HB, const bf16_t* W, bf16_t* BIG, const float* ssp, const float* ssm, bool meta = true) {
    if (meta) { pg8::MEpiSwiGLU ME; ME.O = BIG; ME.ss = ssm; pg8::meta_gemm<DM>(lds, HB, DM, W, 176, 0, ME); }
    pg8::EpiSwiGLU E; E.O = BIG; E.ldo = FF; E.ss = ssp; pg8::run_gemm(lds, HB, DM, W, NGU, DM, 0, E); }
__device__ __forceinline__ void resid_gemm(LAS unsigned char* lds, const bf16_t* A, int lda, const bf16_t* W, int K, int grouped, float* H, bf16_t* HB, const float* bias, const float* scale, float* ssp, float* ssm, bool meta = true) {
    if (meta) { pg8::MEpiResid ME; ME.H = H; ME.bias = bias; ME.scale = scale; ME.HB = HB; ME.ss_out = ssm; if (K == 256) pg8::meta_gemm<256>(lds, A, lda, W, 64, grouped, ME); else if (K == DM) pg8::meta_gemm<DM>(lds, A, lda, W, 64, grouped, ME); else pg8::meta_gemm<FF>(lds, A, lda, W, 64, grouped, ME); }
    pg8::EpiResid E; E.H = H; E.bias = bias; E.scale = scale; E.HB = HB; E.ss_out = ssp; pg8::run_gemm(lds, A, lda, W, DM, K, grouped, E); }
__device__ __forceinline__ void pool_prep(LAS unsigned char* lds, const bf16_t* HB, const float* ssp, const float* ssm, const float* g, bf16_t* Z, int G, int tid) {
    const int C = (MROWS + G - 1) / G; const int r0 = (int)blockIdx.x * C; int r1 = r0 + C; if (r1 > MROWS) r1 = MROWS;
    LAS float* rst = (LAS float*)lds;
    for (int i = tid; i < C + 15; i += 512) { const int row = r0 - 15 + i; float v = 0.f;
        if (row >= 0 && row < r1) { const int pos = row % LSEQ; v = pos < NMETA ? rs64(ssm, pos) : rs16(ssp, row); }
        rst[i] = v; }
    __syncthreads();
    const int cgi = tid & 127, run = tid >> 7, win = 2 << (cgi >> 5);
    const int RL = (r1 - r0 + 3) >> 2; const int ra = r0 + run * RL; int rb = ra + RL; if (rb > r1) rb = r1;
    const f32x4 g0 = *(const f32x4*)(g + cgi * 8), g1 = *(const f32x4*)(g + cgi * 8 + 4);
    float sm[8];
#pragma unroll
    for (int e = 0; e < 8; ++e) sm[e] = 0.f;
#define LDY(dst, row_) do { const u32x4 v_ = *(const u32x4*)(HB + (size_t)(row_) * DM + cgi * 8); const float rs_ = rst[(row_) - r0 + 15]; \
        dst[0] = bflo(v_.x) * rs_; dst[1] = bfhi(v_.x) * rs_; dst[2] = bflo(v_.y) * rs_; dst[3] = bfhi(v_.y) * rs_; dst[4] = bflo(v_.z) * rs_; dst[5] = bfhi(v_.z) * rs_; dst[6] = bflo(v_.w) * rs_; dst[7] = bfhi(v_.w) * rs_; } while (0)
    if (ra < rb) { const int t = ra % LSEQ; const int np = (win - 1) < t ? (win - 1) : t;
        for (int j = 1; j <= np; ++j) { float y[8]; LDY(y, ra - j);
#pragma unroll
            for (int e = 0; e < 8; ++e) sm[e] += y[e]; } }
#pragma unroll 4
    for (int r = ra; r < rb; ++r) {
        const int t = r % LSEQ; float yn[8], yo[8];
        LDY(yn, r);
        const bool drop = (t + 1 >= win); const int ro = drop ? r - win + 1 : r;
        LDY(yo, ro);
        if (t == 0) {
#pragma unroll
            for (int e = 0; e < 8; ++e) sm[e] = 0.f; }
        const int cnt = (t + 1) < win ? (t + 1) : win; const float ic = 1.0f / (float)cnt;
        float o[8];
#pragma unroll
        for (int e = 0; e < 8; ++e) { sm[e] += yn[e]; o[e] = sm[e] * ic - yn[e]; if (drop) sm[e] -= yo[e]; }
        u32x4 w; w.x = pk2(o[0] * g0[0], o[1] * g0[1]); w.y = pk2(o[2] * g0[2], o[3] * g0[3]); w.z = pk2(o[4] * g1[0], o[5] * g1[1]); w.w = pk2(o[6] * g1[2], o[7] * g1[3]);
        *(u32x4*)(Z + (size_t)r * DM + cgi * 8) = w;
    }
#undef LDY
    __syncthreads();
}

__device__ __forceinline__ void grid_bar(unsigned* bar, unsigned target) {
    __syncthreads();
    if (threadIdx.x == 0) {
        __builtin_amdgcn_fence(__ATOMIC_RELEASE, "agent");
        asm volatile("s_waitcnt vmcnt(0)" ::: "memory");
        __hip_atomic_fetch_add(bar, 1u, __ATOMIC_RELAXED, __HIP_MEMORY_SCOPE_AGENT);
        while (__hip_atomic_load(bar, __ATOMIC_RELAXED, __HIP_MEMORY_SCOPE_AGENT) < target) __builtin_amdgcn_s_sleep(1);
        __builtin_amdgcn_fence(__ATOMIC_ACQUIRE, "agent");
        asm volatile("s_waitcnt vmcnt(0)" ::: "memory");
    }
    __syncthreads();
}
__device__ __forceinline__ unsigned xcc_id() { return (unsigned)__builtin_amdgcn_s_getreg((3 << 11) | 20) & 0xFu; }
__device__ __forceinline__ void grid_bar2(unsigned* ctl, const LAS unsigned* lc, unsigned r) {
    __syncthreads();
    if (threadIdx.x == 0) {
        const unsigned x = lc[0], n_x = lc[1], nx = lc[2];
        if (nx < 2u) __builtin_amdgcn_fence(__ATOMIC_RELEASE, "agent");
        asm volatile("s_waitcnt vmcnt(0)" ::: "memory");
        const unsigned a_ = __hip_atomic_fetch_add(ctl + 64 * (17 + x), 1u, __ATOMIC_RELAXED, __HIP_MEMORY_SCOPE_AGENT);
        if (a_ + 1u == r * n_x) {
            __builtin_amdgcn_fence(__ATOMIC_RELEASE, "agent");
            asm volatile("s_waitcnt vmcnt(0)" ::: "memory");
            __hip_atomic_fetch_add(ctl, 1u, __ATOMIC_RELAXED, __HIP_MEMORY_SCOPE_AGENT);
            while (__hip_atomic_load(ctl, __ATOMIC_RELAXED, __HIP_MEMORY_SCOPE_AGENT) < r * nx) __builtin_amdgcn_s_sleep(1);
            __hip_atomic_store(ctl + 64 * (33 + x), r, __ATOMIC_RELAXED, __HIP_MEMORY_SCOPE_AGENT);
        } else {
            while (__hip_atomic_load(ctl + 64 * (33 + x), __ATOMIC_RELAXED, __HIP_MEMORY_SCOPE_AGENT) < r) __builtin_amdgcn_s_sleep(1);
        }
        __builtin_amdgcn_fence(__ATOMIC_ACQUIRE, "agent");
        asm volatile("s_waitcnt vmcnt(0)" ::: "memory");
    }
    __syncthreads();
}
__global__ void __launch_bounds__(512, 2) fwd_kernel(Args a) {
    extern __shared__ __attribute__((aligned(16))) unsigned char shm_raw[];
    LAS unsigned char* lds = (LAS unsigned char*)shm_raw;
    cg::grid_group grid = cg::this_grid();
    const int tid = threadIdx.x, lane = tid & 63, wave = tid >> 6;
    const int G = (int)gridDim.x, gw = (int)blockIdx.x * 8 + wave, NGW = G * 8;
    float* H = (float*)(a.ws + WS_H); bf16_t* Y = (bf16_t*)(a.ws + WS_Y); bf16_t* BIG = (bf16_t*)(a.ws + WS_BIG); bf16_t* Z = (bf16_t*)a.out;
    bf16_t* Wgu = (bf16_t*)(a.ws + WS_WGU); bf16_t* Wd = (bf16_t*)(a.ws + WS_WD); bf16_t* Wqkv = (bf16_t*)(a.ws + WS_WQKV); bf16_t* Wo = (bf16_t*)(a.ws + WS_WO);
    unsigned char* KIMG = a.ws + WS_BIG + (size_t)MP * DM * 2; unsigned char* VIMG = KIMG + (size_t)MP * DM * 2;
    unsigned* BAR = (unsigned*)(a.ws + WS_CTL);
    LAS unsigned* LC = (LAS unsigned*)(lds + LDS_CTL);
    if (threadIdx.x == 0) { const unsigned x_ = xcc_id(); LC[0] = x_; __hip_atomic_fetch_add(BAR + 64 * (1 + x_), 1u, __ATOMIC_RELAXED, __HIP_MEMORY_SCOPE_AGENT); }
    float* SSP = (float*)(a.ws + WS_SS); float* SSM = (float*)(a.ws + WS_SSM);
    bf16_t* Win = (bf16_t*)(a.ws + WS_WIN); bf16_t* Wout = (bf16_t*)(a.ws + WS_WOUT); bf16_t* Wp = (bf16_t*)(a.ws + WS_WP);
    const int lo = a.ph_lo, hi_ = a.ph_hi;
    int ph = 0;
    if (lo < 0) grid.sync();
#define PH_BEGIN if (ph >= lo && ph < hi_) {
#define PH_END } ++ph; if (ph > lo && ph < hi_) { if (ph == 1) { grid_bar(BAR + 64 * 49, (unsigned)G); if (threadIdx.x == 0) { const unsigned x_ = LC[0]; unsigned nx_ = 0; \
        for (int j_ = 0; j_ < 16; ++j_) nx_ += __hip_atomic_load(BAR + 64 * (1 + j_), __ATOMIC_RELAXED, __HIP_MEMORY_SCOPE_AGENT) != 0u; \
        LC[1] = __hip_atomic_load(BAR + 64 * (1 + x_), __ATOMIC_RELAXED, __HIP_MEMORY_SCOPE_AGENT); LC[2] = nx_; } } else grid_bar2(BAR, LC, (unsigned)(ph - 1)); }

    PH_BEGIN
    {
        LAS float* scr = (LAS float*)(lds + wave * 8448);
        for (int l = 0; l < 4; ++l) {
            transpose_matrix(a.f_wg + (size_t)l * DM * FF, DM, FF, Wgu + (size_t)l * NGU * DM, 1, scr, gw, NGW, lane, a.norm_ffn_g + l * DM);
            transpose_matrix(a.f_wu + (size_t)l * DM * FF, DM, FF, Wgu + (size_t)l * NGU * DM, 2, scr, gw, NGW, lane, a.norm_ffn_g + l * DM);
            transpose_matrix(a.f_wd + (size_t)l * FF * DM, FF, DM, Wd + (size_t)l * DM * FF, 0, scr, gw, NGW, lane);
        }
        transpose_matrix(a.w_qkv, DM, NQKV, Wqkv, 0, scr, gw, NGW, lane, a.norm_mix_g + 1 * DM);
        transpose_matrix(a.w_o, DM, DM, Wo, 0, scr, gw, NGW, lane);
        {   const int nblk = 2048 / 32, items = (DM / 64) * nblk;
            for (int it = gw; it < items; it += NGW) { const int kb = it / nblk, nb = it % nblk, n0 = 32 * nb; const int half = n0 >= DM, j0 = n0 - half * DM;
                transpose_item(a.c_win, DM, 2048, Win, 64 * kb, n0, (j0 / 128) * 256 + (j0 % 128) + half * 128, scr, lane, a.norm_mix_g + 2 * DM); } }
        transpose_matrix(a.c_wout, DM, DM, Wout, 0, scr, gw, NGW, lane);
        for (int jg = 0; jg < 8; ++jg) transpose_matrix(a.pool_w + (size_t)jg * 256 * 256, 256, 256, Wp + (size_t)jg * 256 * 256, 0, scr, gw, NGW, lane);
#pragma unroll 2
        for (int r = gw; r < MROWS; r += NGW) { const int b = r / LSEQ, p = r % LSEQ;
            const float* src = p < NMETA ? a.meta + (size_t)p * DM : a.x + ((size_t)b * SEQ + (p - NMETA)) * DM;
            init_row(src, H + (size_t)r * DM, Y + (size_t)r * DM, SSP + (size_t)r * 16, r < NMETA ? SSM + r * 64 : nullptr, lane); }
        for (int i = (int)blockIdx.x * 512 + tid; i < (MP - MROWS) * DM / 8; i += G * 512) { const u32x4 z = {0u, 0u, 0u, 0u};
            *((u32x4*)(Y + (size_t)MROWS * DM) + i) = z; *((u32x4*)(Z + (size_t)MROWS * DM) + i) = z; }
    }
    PH_END

    PH_BEGIN pool_prep(lds, Y, SSP, SSM, a.norm_mix_g + 0 * DM, Z, G, tid); PH_END
    PH_BEGIN resid_gemm(lds, Z, DM, Wp, 256, 1, H, Y, a.pool_b, a.pool_scale, SSP, SSM); PH_END
    PH_BEGIN ffn_up(lds, Y, Wgu + (size_t)0 * NGU * DM, BIG, SSP, SSM); PH_END
    PH_BEGIN resid_gemm(lds, BIG, FF, Wd + (size_t)0 * DM * FF, FF, 0, H, Y, nullptr, nullptr, SSP, SSM); PH_END
    PH_BEGIN { { pg8::MEpiQKV ME; ME.Q = BIG; ME.Kimg = KIMG; ME.Vimg = VIMG; ME.ss = SSM; pg8::meta_gemm<DM>(lds, Y, DM, Wqkv, 192, 0, ME); } pg8::EpiQKV E; E.Q = BIG; E.Kimg = KIMG; E.Vimg = VIMG; E.ss = SSP; pg8::run_gemm(lds, Y, DM, Wqkv, NQKV, DM, 0, E); } PH_END
    PH_BEGIN
    {
        const float lam_init = 0.8f - 0.6f * expf(-0.3f * 1.0f);
        float d1 = a.lq1[lane] * a.lk1[lane], d2 = a.lq2[lane] * a.lk2[lane];
        d1 = wave_sum(d1); d2 = wave_sum(d2);
        const float lam = expf(d1) - expf(d2) + lam_init;
        const int NU = 2048 + 16;
        for (int i = 0;; ++i) {
            const int v = (i & 1) ? (G - 1 - (int)blockIdx.x) : (int)blockIdx.x;
            const int p = i * G + v;
            if (i * G >= NU) break;
            if (p >= NU) continue;
            int bh, qpos0, ntiles, slim;
            if (p < 2048) { const int jq = 127 - (p >> 4); bh = p & 15; qpos0 = NMETA + 128 * jq; ntiles = 2 * jq + 3; slim = LSEQ; }
            else { bh = p - 2048; qpos0 = 0; ntiles = 1; slim = NMETA; }
            att::attn_unit(lds, BIG, KIMG, VIMG, Z, bh >> 3, bh & 7, qpos0, ntiles, slim, a.relb, a.subg, lam, 1.0f - lam_init);
        }
    }
    PH_END
    PH_BEGIN resid_gemm(lds, Z, DM, Wo, DM, 0, H, Y, nullptr, nullptr, SSP, SSM); PH_END
    PH_BEGIN ffn_up(lds, Y, Wgu + (size_t)1 * NGU * DM, BIG, SSP, SSM); PH_END
    PH_BEGIN resid_gemm(lds, BIG, FF, Wd + (size_t)1 * DM * FF, FF, 0, H, Y, nullptr, nullptr, SSP, SSM); PH_END
    PH_BEGIN { { pg8::MEpiGLU ME; ME.O = BIG; ME.bias = a.c_bin; ME.ss = SSM; pg8::meta_gemm<DM>(lds, Y, DM, Win, 64, 0, ME); } pg8::EpiGLU E; E.O = BIG; E.bias = a.c_bin; E.ss = SSP; pg8::run_gemm(lds, Y, DM, Win, 2048, DM, 0, E); } PH_END
    PH_BEGIN
    {
        const int c2 = 2 * tid;
        float wv[31][2];
#pragma unroll
        for (int j = 0; j < 31; ++j) { wv[j][0] = a.c_dww[j * DM + c2]; wv[j][1] = a.c_dww[j * DM + c2 + 1]; }
        const float db0 = a.c_dwb[c2], db1 = a.c_dwb[c2 + 1];
        const int TPB = (LSEQ + 15) / 16, NT_ = BATCH * TPB;
        for (int tile = (int)blockIdx.x; tile < NT_; tile += G) {
            const int b = tile / TPB, t0 = (tile % TPB) * 16; const size_t rb = (size_t)b * LSEQ;
            {
                u32x4 sv[12];
#pragma unroll
                for (int k = 0; k < 12; ++k) { const int gi = tid + 512 * k, rr = gi >> 7, cc = gi & 127; const int t = t0 - 30 + rr;
                    sv[k] = (u32x4){0u, 0u, 0u, 0u}; if (gi < 46 * 128 && t >= 0 && t < LSEQ) sv[k] = *(const u32x4*)(BIG + (rb + t) * DM + cc * 8); }
#pragma unroll
                for (int k = 0; k < 12; ++k) { const int gi = tid + 512 * k, rr = gi >> 7, cc = gi & 127; if (gi < 46 * 128) *(LAS u32x4*)(lds + rr * 2048 + cc * 16) = sv[k]; }
            }
            __syncthreads();
            float acc[16][2];
#pragma unroll
            for (int r = 0; r < 16; ++r) { acc[r][0] = db0; acc[r][1] = db1; }
#pragma unroll
            for (int j = 0; j < 31; ++j) {
#pragma unroll
                for (int r = 0; r < 16; ++r) { const unsigned w = *(const LAS unsigned*)(lds + (r + j) * 2048 + tid * 4);
                    acc[r][0] += wv[j][0] * bflo(w); acc[r][1] += wv[j][1] * bfhi(w); } }
            __syncthreads();
#pragma unroll
            for (int r = 0; r < 16; ++r) { f32x2_t v = {acc[r][0], acc[r][1]}; *(LAS f32x2_t*)(lds + r * 4096 + tid * 8) = v; }
            __syncthreads();
            for (int rr = 0; rr < 2; ++rr) { const int r = wave * 2 + rr, t = t0 + r;
                if (t < LSEQ) {
                    f32x4 v[4]; float s = 0.f;
#pragma unroll
                    for (int j = 0; j < 4; ++j) { v[j] = *(const LAS f32x4*)(lds + r * 4096 + (lane + 64 * j) * 16); s += (v[j].x + v[j].y) + (v[j].z + v[j].w); }
                    const float mu = wave_sum(s) * (1.0f / DM); float s2 = 0.f;
#pragma unroll
                    for (int j = 0; j < 4; ++j) { v[j] = v[j] - mu; s2 += (v[j].x * v[j].x + v[j].y * v[j].y) + (v[j].z * v[j].z + v[j].w * v[j].w); }
                    const float rstd = 1.0f / sqrtf(wave_sum(s2) * (1.0f / DM) + 1e-5f);
#pragma unroll
                    for (int j = 0; j < 4; ++j) { const f32x4 gv = *((const f32x4*)a.c_lng + lane + 64 * j), bv = *((const f32x4*)a.c_lnb + lane + 64 * j);
                        f32x4 y = v[j] * rstd * gv + bv; y.x *= sigmoidf_(y.x); y.y *= sigmoidf_(y.y); y.z *= sigmoidf_(y.z); y.w *= sigmoidf_(y.w);
                        u32x2 o; o.x = pk2(y.x, y.y); o.y = pk2(y.z, y.w); *((u32x2*)(Z + (rb + t) * DM) + lane + 64 * j) = o; }
                } }
            __syncthreads();
        }
    }
    PH_END
    PH_BEGIN resid_gemm(lds, Z, DM, Wout, DM, 0, H, Y, a.c_bout, nullptr, SSP, SSM); PH_END
    PH_BEGIN ffn_up(lds, Y, Wgu + (size_t)2 * NGU * DM, BIG, SSP, SSM); PH_END
    PH_BEGIN resid_gemm(lds, BIG, FF, Wd + (size_t)2 * DM * FF, FF, 0, H, Y, nullptr, nullptr, SSP, SSM); PH_END
    PH_BEGIN pool_prep(lds, Y, SSP, SSM, a.norm_mix_g + 3 * DM, Z, G, tid); PH_END
    PH_BEGIN resid_gemm(lds, Z, DM, Wp + (size_t)4 * 256 * 256, 256, 1, H, Y, a.pool_b + DM, a.pool_scale + DM, SSP, SSM, false); PH_END
    PH_BEGIN ffn_up(lds, Y, Wgu + (size_t)3 * NGU * DM, BIG, SSP, SSM, false); PH_END
    PH_BEGIN resid_gemm(lds, BIG, FF, Wd + (size_t)3 * DM * FF, FF, 0, H, Y, nullptr, nullptr, SSP, SSM, false); PH_END
    PH_BEGIN
    for (int r = gw; r < BATCH * SEQ; r += NGW) { const int b = r / SEQ, t = r % SEQ;
        const bf16_t* hp = Y + ((size_t)b * LSEQ + NMETA + t) * DM; f32x4 v[4]; float sq = 0.f;
#pragma unroll
        for (int j = 0; j < 4; ++j) { const u32x2 w = *((const u32x2*)hp + lane + 64 * j); v[j] = (f32x4){bflo(w.x), bfhi(w.x), bflo(w.y), bfhi(w.y)}; sq += (v[j].x * v[j].x + v[j].y * v[j].y) + (v[j].z * v[j].z + v[j].w * v[j].w); }
        const float rs = 1.0f / sqrtf(wave_sum(sq) * (1.0f / DM) + 1e-6f);
#pragma unroll
        for (int j = 0; j < 4; ++j) { const f32x4 gv = *((const f32x4*)a.final_g + lane + 64 * j); *((f32x4*)(a.out + (size_t)r * DM) + lane + 64 * j) = v[j] * rs * gv; } }
    PH_END
#undef PH_BEGIN
#undef PH_END
}
constexpr int N_PHASES = 20;

#ifndef MK_MULTI
#define MK_MULTI 0
#endif

extern "C" void kernel_launch(void* const* d_in, const int* in_sizes, int n_in, void* d_out, int out_size, void* d_ws, size_t ws_size, hipStream_t stream) {
    static int grid = 0;
    if (grid == 0) {
        if (n_in != 27 || ws_size < WS_END) { fprintf(stderr, "kernel_launch: unexpected n_in %d / ws_size %zu (need %zu)\n", n_in, ws_size, (size_t)WS_END); grid = -1; return; }
        int dev = 0, cus = 0, per_cu = 0;
        hipGetDevice(&dev); hipDeviceGetAttribute(&cus, hipDeviceAttributeMultiprocessorCount, dev);
        if (hipFuncSetAttribute((const void*)fwd_kernel, hipFuncAttributeMaxDynamicSharedMemorySize, LDS_BYTES) != hipSuccess) { fprintf(stderr, "kernel_launch: hipFuncSetAttribute failed\n"); grid = -1; return; }
        if (hipOccupancyMaxActiveBlocksPerMultiprocessor(&per_cu, (const void*)fwd_kernel, 512, LDS_BYTES) != hipSuccess || per_cu < 1) { fprintf(stderr, "kernel_launch: occupancy query gave %d\n", per_cu); per_cu = 1; }
        (void)hipGetLastError();
        grid = cus * per_cu;
        fprintf(stderr, "kernel_launch: grid %d (%d CUs x %d)\n", grid, cus, per_cu);
    }
    if (grid < 0) return;
    Args a{};
    const float** f = (const float**)&a;
    for (int i = 0; i < 27; ++i) f[i] = (const float*)d_in[i];
    a.out = (float*)d_out; a.ws = (unsigned char*)d_ws;
#if MK_MULTI
    for (int p = 0; p < N_PHASES; ++p) { a.ph_lo = p; a.ph_hi = p + 1; void* args[] = {&a};
        hipError_t e = hipLaunchCooperativeKernel((const void*)fwd_kernel, dim3(grid), dim3(512), args, LDS_BYTES, stream);
        if (e != hipSuccess) { fprintf(stderr, "launch %d failed: %s\n", p, hipGetErrorString(e)); break; } }
#else
    if (hipMemsetAsync((char*)d_ws + WS_CTL, 0, 16384, stream) != hipSuccess) { fprintf(stderr, "kernel_launch: memset of the barrier word failed\n"); return; }
    a.ph_lo = 0; a.ph_hi = N_PHASES; void* args[] = {&a};
    hipError_t e = hipLaunchCooperativeKernel((const void*)fwd_kernel, dim3(grid), dim3(512), args, LDS_BYTES, stream);
    if (e != hipSuccess) fprintf(stderr, "cooperative launch failed: %s (grid %d)\n", hipGetErrorString(e), grid);
#endif
}
```
